# Optimizing an MI355X kernel written in HIP

```python
import math
import jax, jax.numpy as jnp
from jax import lax
import numpy as np

D_MODEL = 1024
BATCH = 4
SEQ = 4096
DEPTH = 4

N_MIXERS = 2
N_RET_LAYERS = (DEPTH + N_MIXERS - 1) // N_MIXERS
N_SB_LAYERS = DEPTH // N_MIXERS
PLE_DIM = 256
D_FF = 2816
FFN_RES_WEIGHT = 0.5
RET_HEADS = 4
RET_DK = D_MODEL // RET_HEADS
RET_QK = RET_HEADS * RET_DK
RET_DV = 2 * RET_DK
RET_V = RET_HEADS * RET_DV
RET_IN = 2 * RET_QK + 2 * RET_V
RET_CHUNK = 128
ROPE_BASE = 10000.0
GN_EPS = 1e-5
SB_HEADS = 8
SB_DH = D_MODEL // SB_HEADS
SB_WIDTH = SB_HEADS * SB_DH
SB_IN = 3 * SB_WIDTH
SB_BLOCK = 128
N_NORMS = 8
RMS_EPS = 1e-6

kernel_name = "hybrid_retention_stickbreaking_macaron_trunk"


def rmsnorm(x, g):
    xf = x.astype(jnp.float32)
    y = xf * lax.rsqrt(jnp.mean(xf * xf, axis=-1, keepdims=True) + RMS_EPS)
    return (y * g.astype(jnp.float32)).astype(x.dtype)


def swiglu(x, w_gate, w_up, w_down):
    return (jax.nn.silu(x @ w_gate) * (x @ w_up)) @ w_down


def rope(t, positions):
    half = t.shape[-1] // 2
    inv = ROPE_BASE ** (-jnp.arange(half, dtype=jnp.float32) / half)
    ang = positions.astype(jnp.float32)[..., None] * inv
    cos = jnp.cos(ang)[:, :, None, :]
    sin = jnp.sin(ang)[:, :, None, :]
    t1, t2 = t[..., :half], t[..., half:]
    return jnp.concatenate([t1 * cos - t2 * sin, t1 * sin + t2 * cos], axis=-1)


def retention(h, positions, w_in, gn_gain, w_out):
    B, S, _ = h.shape
    proj = h @ w_in
    q, k, v, g = jnp.split(proj, [RET_QK, 2 * RET_QK, 2 * RET_QK + RET_V], axis=-1)
    q = rope(q.astype(jnp.float32).reshape(B, S, RET_HEADS, RET_DK), positions)
    k = rope(k.astype(jnp.float32).reshape(B, S, RET_HEADS, RET_DK), positions) * (RET_DK ** -0.5)
    v = v.astype(jnp.float32).reshape(B, S, RET_HEADS, RET_DV)

    nc = S // RET_CHUNK
    def to_chunks(t):
        return t.reshape(B, nc, RET_CHUNK, RET_HEADS, -1).transpose(1, 0, 3, 2, 4)
    qc, kc, vc = to_chunks(q), to_chunks(k), to_chunks(v)

    log_gamma = jnp.log1p(-jnp.exp2(-5.0 - jnp.arange(RET_HEADS, dtype=jnp.float32)))
    idx = jnp.arange(RET_CHUNK, dtype=jnp.float32)
    rel = idx[:, None] - idx[None, :]
    inner_decay = jnp.where(rel[None] >= 0,
                            jnp.exp(jnp.maximum(rel, 0.0)[None] * log_gamma[:, None, None]),
                            0.0)
    xi = jnp.exp((idx + 1.0)[None, :] * log_gamma[:, None])
    zeta = jnp.exp((RET_CHUNK - 1.0 - idx)[None, :] * log_gamma[:, None])
    chunk_decay = jnp.exp(RET_CHUNK * log_gamma)

    def step(state, inp):
        qi, ki, vi = inp
        scores = jnp.einsum('bhid,bhjd->bhij', qi, ki) * inner_decay[None]
        o_inner = jnp.einsum('bhij,bhjv->bhiv', scores, vi)
        o_cross = jnp.einsum('bhid,bhdv->bhiv', qi, state) * xi[None, :, :, None]
        new_state = state * chunk_decay[None, :, None, None] + jnp.einsum(
            'bhjd,bhjv->bhdv', ki * zeta[None, :, :, None], vi)
        return new_state, o_inner + o_cross

    state0 = jnp.zeros((B, RET_HEADS, RET_DK, RET_DV), jnp.float32)
    _, o = lax.scan(step, state0, (qc, kc, vc))
    o = o.transpose(1, 0, 3, 2, 4).reshape(B, S, RET_HEADS, RET_DV)
    mu = jnp.mean(o, axis=-1, keepdims=True)
    var = jnp.mean(jnp.square(o - mu), axis=-1, keepdims=True)
    o = ((o - mu) * lax.rsqrt(var + GN_EPS)).reshape(B, S, RET_V) * gn_gain.astype(jnp.float32)
    o = jax.nn.silu(g.astype(jnp.float32)) * o
    return o.astype(h.dtype) @ w_out


def stick_breaking(h, w_in, w_out):
    B, S, _ = h.shape
    proj = h @ w_in
    q, k, v = jnp.split(proj, [SB_WIDTH, 2 * SB_WIDTH], axis=-1)
    def heads(t):
        return t.astype(jnp.float32).reshape(B, S, SB_HEADS, SB_DH).transpose(0, 2, 1, 3)
    q, k, v = heads(q), heads(k), heads(v)
    scale = SB_DH ** -0.5
    nb = S // SB_BLOCK
    qb = q.reshape(B, SB_HEADS, nb, SB_BLOCK, SB_DH).transpose(2, 0, 1, 3, 4)
    kpos = jnp.arange(S)

    def block(args):
        q_blk, b = args
        qpos = b * SB_BLOCK + jnp.arange(SB_BLOCK)
        z = jnp.einsum('bhqd,bhkd->bhqk', q_blk, k) * scale
        mask = (kpos[None, :] < qpos[:, None])[None, None]
        log_one_minus = jnp.where(mask, jax.nn.log_sigmoid(-z), 0.0)
        rem = lax.cumsum(log_one_minus, axis=3, reverse=True) - log_one_minus
        a = jnp.where(mask, jnp.exp(jax.nn.log_sigmoid(z) + rem), 0.0)
        return jnp.einsum('bhqk,bhkd->bhqd', a, v)

    o = lax.map(block, (qb, jnp.arange(nb)))
    o = o.transpose(1, 0, 3, 2, 4).reshape(B, S, SB_WIDTH)
    return o.astype(h.dtype) @ w_out


def setup_inputs(seed: int = 0) -> dict:
    key = jax.random.key(seed)
    ks = jax.random.split(key, 16)
    f32 = jnp.float32
    def w(k, shape, fan_in):
        return jax.random.normal(k, shape, f32) * (fan_in ** -0.5)
    x = jax.random.normal(ks[0], (BATCH, SEQ, D_MODEL), f32)
    p = jax.random.normal(ks[1], (DEPTH, BATCH, SEQ, PLE_DIM), f32)
    positions = jnp.broadcast_to(jnp.arange(SEQ, dtype=jnp.int32), (BATCH, SEQ))
    norm_gains = 1.0 + 0.05 * jax.random.normal(ks[2], (DEPTH, N_NORMS, D_MODEL), f32)
    ffn_w_gate = w(ks[3], (DEPTH, 2, D_MODEL, D_FF), D_MODEL)
    ffn_w_up = w(ks[4], (DEPTH, 2, D_MODEL, D_FF), D_MODEL)
    ffn_w_down = w(ks[5], (DEPTH, 2, D_FF, D_MODEL), D_FF)
    ret_w_in = w(ks[6], (N_RET_LAYERS, D_MODEL, RET_IN), D_MODEL)
    ret_gn_gain = 1.0 + 0.05 * jax.random.normal(ks[7], (N_RET_LAYERS, RET_V), f32)
    ret_w_out = w(ks[8], (N_RET_LAYERS, RET_V, D_MODEL), RET_V)
    sb_w_in = w(ks[9], (N_SB_LAYERS, D_MODEL, SB_IN), D_MODEL)
    sb_w_out = w(ks[10], (N_SB_LAYERS, SB_WIDTH, D_MODEL), SB_WIDTH)
    ple_w_gate = w(ks[11], (DEPTH, D_MODEL, D_MODEL), D_MODEL)
    ple_w_proj = w(ks[12], (DEPTH, PLE_DIM, D_MODEL), PLE_DIM)
    return {"x": x, "p": p, "positions": positions, "norm_gains": norm_gains,
            "ffn_w_gate": ffn_w_gate, "ffn_w_up": ffn_w_up, "ffn_w_down": ffn_w_down,
            "ret_w_in": ret_w_in, "ret_gn_gain": ret_gn_gain, "ret_w_out": ret_w_out,
            "sb_w_in": sb_w_in, "sb_w_out": sb_w_out,
            "ple_w_gate": ple_w_gate, "ple_w_proj": ple_w_proj}


def reference(x, p, positions, norm_gains, ffn_w_gate, ffn_w_up, ffn_w_down,
              ret_w_in, ret_gn_gain, ret_w_out, sb_w_in, sb_w_out,
              ple_w_gate, ple_w_proj):
    h = x
    for i in range(DEPTH):
        g = norm_gains[i]
        f = swiglu(rmsnorm(h, g[0]), ffn_w_gate[i, 0], ffn_w_up[i, 0], ffn_w_down[i, 0])
        h = h + FFN_RES_WEIGHT * rmsnorm(f, g[1])
        m_in = rmsnorm(h, g[2])
        j = i // N_MIXERS
        if i % N_MIXERS == 0:
            m = retention(m_in, positions, ret_w_in[j], ret_gn_gain[j], ret_w_out[j])
        else:
            m = stick_breaking(m_in, sb_w_in[j], sb_w_out[j])
        h = h + rmsnorm(m, g[3])
        f = swiglu(rmsnorm(h, g[4]), ffn_w_gate[i, 1], ffn_w_up[i, 1], ffn_w_down[i, 1])
        h = h + FFN_RES_WEIGHT * rmsnorm(f, g[5])
        gate = jax.nn.sigmoid(rmsnorm(h, g[6]) @ ple_w_gate[i])
        e = p[i] @ ple_w_proj[i]
        h = h + rmsnorm(gate * e, g[7])
    return h
```

```cpp
#include <hip/hip_runtime.h>
#include <cstdio>
#include <cstdint>

constexpr int D = 1024, BATCH = 4, SEQ = 4096, DEPTH = 4, M = BATCH * SEQ;
constexpr int PLE = 256, FF = 2816;
constexpr int RH = 4, RDK = 256, RDV = 512, RQK = 1024, RV = 2048, RIN = 6144;
constexpr int SH = 8, SDH = 128, SW = 1024, SIN = 3072;
constexpr float RMS_EPS = 1e-6f, GN_EPS = 1e-5f;
#define LAS __attribute__((address_space(3)))
typedef unsigned short bf16;
typedef unsigned v4u __attribute__((ext_vector_type(4)));
typedef float f32x4 __attribute__((ext_vector_type(4)));
__device__ __forceinline__ unsigned f2bf(float f) { unsigned u = __builtin_bit_cast(unsigned, f); return (u + 0x7fffu + ((u >> 16) & 1u)) >> 16; }
__device__ __forceinline__ unsigned pk2(float lo, float hi) { return f2bf(lo) | (f2bf(hi) << 16); }
#define XB_TMO      128
#define XB_XCNT(j)  (256  + 64 * (j))
#define XB_XSUB(j)  (1280 + 64 * (j))
#define XB_XGEN(j)  (2304 + 64 * (j))
#define XB_TOP      3328
#define XB_TOPGEN   3392
#define XCD_BAR_WORDS 3456
#define XB_SPIN_CAP (1u << 18)

__device__ __forceinline__ unsigned xb_ld(unsigned* p)              { return __hip_atomic_load(p, __ATOMIC_RELAXED, __HIP_MEMORY_SCOPE_AGENT); }
__device__ __forceinline__ unsigned xb_add(unsigned* p, unsigned v) { return __hip_atomic_fetch_add(p, v, __ATOMIC_RELAXED, __HIP_MEMORY_SCOPE_AGENT); }
__device__ __forceinline__ unsigned xb_xcc_id() { return (unsigned)__builtin_amdgcn_s_getreg((3 << 11) | 20) & 0xFu; }
#define XB_SPIN(cond, bar) do { unsigned _sp = 0; while (cond) { __builtin_amdgcn_s_sleep(1); \
    if ((++_sp & 255u) == 0u) { if (xb_ld(&(bar)[XB_TMO])) break; if (_sp > XB_SPIN_CAP) { atomicAdd(&(bar)[XB_TMO], 1u); break; } } } } while (0)

struct XcdBarrier {
    unsigned* bar; unsigned x;
    volatile LAS unsigned* st;
};

__device__ __forceinline__ XcdBarrier xcd_barrier_post(unsigned* bar, volatile LAS unsigned* st) {
    XcdBarrier b; b.bar = bar; b.x = xb_xcc_id(); b.st = st;
    if (threadIdx.x == 0) (void)xb_add(&bar[XB_XCNT(b.x)], 1u);
    return b;
}
__device__ __forceinline__ void xcd_barrier_complete(unsigned* bar, unsigned x, unsigned& nloc, unsigned& nx) {
    const unsigned G = gridDim.x * gridDim.y * gridDim.z;
    unsigned sum, cnt, mine, sp = 0u;
    for (;;) {
        sum = 0u; cnt = 0u; mine = 0u;
#pragma unroll
        for (unsigned j = 0; j < 16; ++j) { const unsigned c = xb_ld(&bar[XB_XCNT(j)]); sum += c; cnt += (c > 0u) ? 1u : 0u; mine = (j == x) ? c : mine; }
        if (sum == G) break;
        __builtin_amdgcn_s_sleep(1);
        if ((++sp & 255u) == 0u) { if (xb_ld(&bar[XB_TMO])) break; if (sp > XB_SPIN_CAP) { atomicAdd(&bar[XB_TMO], 1u); break; } }
    }
    nloc = mine > 0u ? mine : 1u; nx = cnt > 0u ? cnt : 1u;
}

__device__ __forceinline__ void xcd_barrier(const XcdBarrier& b) {
    asm volatile("s_waitcnt vmcnt(0)" ::: "memory");
    __syncthreads();
    if (threadIdx.x == 0) {
        unsigned* bar = b.bar;
        __builtin_amdgcn_s_waitcnt(0);
        unsigned nloc = b.st[0], nx = b.st[1];
        if (nloc == 0u) { xcd_barrier_complete(bar, b.x, nloc, nx); b.st[0] = nloc; b.st[1] = nx; }
        const unsigned old = xb_add(&bar[XB_XSUB(b.x)], 1u);
        const unsigned gen = old / nloc;
        if (old + 1u == (gen + 1u) * nloc) {
            __builtin_amdgcn_fence(__ATOMIC_RELEASE, "agent");
            asm volatile("s_waitcnt vmcnt(0)" ::: "memory");
            const unsigned og = xb_add(&bar[XB_TOP], 1u);
            const unsigned tg = og / nx;
            if (og + 1u == (tg + 1u) * nx) xb_add(&bar[XB_TOPGEN], 1u);
            else XB_SPIN(xb_ld(&bar[XB_TOPGEN]) == tg, bar);
            __builtin_amdgcn_fence(__ATOMIC_ACQUIRE, "agent");
            xb_add(&bar[XB_XGEN(b.x)], 1u);
            asm volatile("s_waitcnt vmcnt(0)" ::: "memory");
        } else {
            XB_SPIN(xb_ld(&bar[XB_XGEN(b.x)]) == gen, bar);
            __builtin_amdgcn_fence(__ATOMIC_ACQUIRE, "agent");
            asm volatile("s_waitcnt vmcnt(0)" ::: "memory");
        }
    }
    __syncthreads();
}

namespace pg8 {
#define PG8_LAS __attribute__((address_space(3)))
typedef unsigned short bf16_t;
typedef short bf16x8 __attribute__((ext_vector_type(8)));
typedef float f32x4 __attribute__((ext_vector_type(4)));
typedef unsigned u32x4 __attribute__((ext_vector_type(4)));
constexpr int BM = 256, BK = 64, HALF = 128, HTB = HALF * BK * 2  , STAGE_BYTES = 8 * HTB, NXCD = 8, WGM = 8;

__host__ __device__ __forceinline__ int lds_byte(int r, int c) { const int st = (r >> 4) * 2 + (c >> 5), rr = r & 15, cc = c & 31, ob = rr * 64 + cc * 2; return st * 1024 + (ob ^ (((ob >> 9) & 1) << 5)); }
__host__ __device__ __forceinline__ void stage_rc(int b, int& R, int& C) { const int st = b / 1024, sb = b % 1024, swz = sb ^ (((sb >> 9) & 1) << 5); R = (st >> 1) * 16 + swz / 64; C = (st & 1) * 32 + (swz % 64) / 2; }
__host__ __device__ __forceinline__ int perm32(int rho) { const int n = rho >> 4, i = rho & 15; return 8 * (i >> 2) + 4 * n + (i & 3); }

struct Unit { int pm, pn; };
struct Gemm { const bf16_t* A; const bf16_t* Bt; int M, N, K, lda; };

struct StaticOrder {
    int nM, nN, nwg, G, c;
    __host__ __device__ void init(int M, int N, int G_, int c_) { nM = M / BM; nN = N / BM; nwg = nM * nN; G = G_; c = c_; }
    __host__ __device__ bool next(int i, Unit& u) const {
        const long L = (long)i * G + c; if (L >= nwg) return false;
        int wgid = (int)L; { const int q = nwg / NXCD, r = nwg % NXCD, xcd = wgid % NXCD, off = wgid / NXCD; wgid = (xcd < r ? xcd * (q + 1) : r * (q + 1) + (xcd - r) * q) + off; }
        const int nig = WGM * nN, gid = wgid / nig, fm = gid * WGM, gsz = (nM - fm) < WGM ? (nM - fm) : WGM;
        u.pm = fm + ((wgid % nig) % gsz); u.pn = (wgid % nig) / gsz; return true;
    }
    __device__ __forceinline__ void a_ready(const Unit&) const {}
    __device__ __forceinline__ void done(const Unit&) const {}
};
__device__ __forceinline__ unsigned cvt_pk_bf16(float lo, float hi) { unsigned r; asm volatile("v_cvt_pk_bf16_f32 %0, %1, %2" : "=v"(r) : "v"(lo), "v"(hi)); return r; }
typedef float f32x2 __attribute__((ext_vector_type(2)));
__device__ __forceinline__ float silu_fast(float x) { return x * __builtin_amdgcn_rcpf(1.f + __builtin_amdgcn_exp2f(-1.4426950408889634f * x)); }
__device__ __forceinline__ float sigmoid_fast(float x) { return __builtin_amdgcn_rcpf(1.f + __builtin_amdgcn_exp2f(-1.4426950408889634f * x)); }
__device__ __forceinline__ u32x4 pack8v(const f32x4 a, const f32x4 b) { u32x4 w; w.x = cvt_pk_bf16(a[0], a[1]); w.y = cvt_pk_bf16(a[2], a[3]); w.z = cvt_pk_bf16(b[0], b[1]); w.w = cvt_pk_bf16(b[2], b[3]); return w; }
struct EpiF32 {
    static constexpr bool PERM = false, AFTER_DRAIN = false;
    float* C; int ldc; int pad;
    __device__ __forceinline__ void operator()(const f32x4 (&acc)[2][2][4][2], const Unit& u, int wr, int wc, int fr, int fq) const {
        const int row0 = u.pm * BM + wr * 64 + fr, col0 = u.pn * BM + wc * 32 + 4 * fq;
#pragma unroll
        for (int ai = 0; ai < 2; ++ai)
#pragma unroll
            for (int m = 0; m < 4; ++m) { float* rowp = C + (size_t)(row0 + ai * HALF + m * 16) * ldc + col0;
#pragma unroll
                for (int bj = 0; bj < 2; ++bj)
#pragma unroll
                    for (int n = 0; n < 2; ++n) *(f32x4*)(rowp + bj * HALF + n * 16) = acc[ai][bj][m][n]; }
    }
    __device__ __forceinline__ void fused(f32x4 (&acc)[2][2][4][2], const Unit& u, int wr, int wc, int fr, int fq, PG8_LAS unsigned char* lds, int wid, int lane) const {}
};
struct EpiGateMul {
    static constexpr bool PERM = false, AFTER_DRAIN = false;
    float* C; const float* E; int ldc; int pad;
    __device__ __forceinline__ void operator()(const f32x4 (&acc)[2][2][4][2], const Unit& u, int wr, int wc, int fr, int fq) const {
        const int row0 = u.pm * BM + wr * 64 + fr, col0 = u.pn * BM + wc * 32 + 4 * fq;
#pragma unroll
        for (int ai = 0; ai < 2; ++ai)
#pragma unroll
            for (int m = 0; m < 4; ++m) { const size_t off = (size_t)(row0 + ai * HALF + m * 16) * ldc + col0;
#pragma unroll
                for (int bj = 0; bj < 2; ++bj)
#pragma unroll
                    for (int n = 0; n < 2; ++n) { const f32x4 e = *(const f32x4*)(E + off + bj * HALF + n * 16); const f32x4 a = acc[ai][bj][m][n]; f32x4 o;
#pragma unroll
                        for (int j = 0; j < 4; ++j) o[j] = sigmoid_fast(a[j]) * e[j];
                        *(f32x4*)(C + off + bj * HALF + n * 16) = o; } }
    }
    __device__ __forceinline__ void fused(f32x4 (&acc)[2][2][4][2], const Unit& u, int wr, int wc, int fr, int fq, PG8_LAS unsigned char* lds, int wid, int lane) const {}
};
struct EpiBf16 {
    static constexpr bool PERM = true, AFTER_DRAIN = false;
    bf16_t* O; int ldc; int pad;
    __device__ __forceinline__ void operator()(const f32x4 (&acc)[2][2][4][2], const Unit& u, int wr, int wc, int fr, int fq) const {
        const int row0 = u.pm * BM + wr * 64 + fr, col0 = u.pn * BM + wc * 32 + 8 * fq;
#pragma unroll
        for (int ai = 0; ai < 2; ++ai)
#pragma unroll
            for (int m = 0; m < 4; ++m) { bf16_t* rowp = O + (size_t)(row0 + ai * HALF + m * 16) * ldc + col0;
#pragma unroll
                for (int bj = 0; bj < 2; ++bj) *(u32x4*)(rowp + bj * HALF) = pack8v(acc[ai][bj][m][0], acc[ai][bj][m][1]); }
    }
    __device__ __forceinline__ void fused(f32x4 (&acc)[2][2][4][2], const Unit& u, int wr, int wc, int fr, int fq, PG8_LAS unsigned char* lds, int wid, int lane) const {}
};
struct EpiSwiglu {
    static constexpr bool PERM = true, AFTER_DRAIN = false;
    bf16_t* O; int ldc; int pad;
    __device__ __forceinline__ void operator()(const f32x4 (&acc)[2][2][4][2], const Unit& u, int wr, int wc, int fr, int fq) const {
        const int row0 = u.pm * BM + wr * 64 + fr, col0 = u.pn * HALF + wc * 32 + 8 * fq;
#pragma unroll
        for (int ai = 0; ai < 2; ++ai)
#pragma unroll
            for (int m = 0; m < 4; ++m) { bf16_t* rowp = O + (size_t)(row0 + ai * HALF + m * 16) * ldc + col0; f32x4 v0, v1;
#pragma unroll
                for (int j = 0; j < 4; ++j) { v0[j] = silu_fast(acc[ai][0][m][0][j]) * acc[ai][1][m][0][j]; v1[j] = silu_fast(acc[ai][0][m][1][j]) * acc[ai][1][m][1][j]; }
                *(u32x4*)rowp = pack8v(v0, v1); }
    }
    __device__ __forceinline__ void fused(f32x4 (&acc)[2][2][4][2], const Unit& u, int wr, int wc, int fr, int fq, PG8_LAS unsigned char* lds, int wid, int lane) const {}
};
struct EpiRetIn {
    static constexpr bool PERM = true, AFTER_DRAIN = false;
    bf16_t* O; const float* cs; const float* sn;
    __device__ __forceinline__ void operator()(const f32x4 (&acc)[2][2][4][2], const Unit& u, int wr, int wc, int fr, int fq) const {
        const int row0 = u.pm * BM + wr * 64 + fr, d0 = wc * 32 + 8 * fq, ldc = 6144;
        if (u.pn < 8) {
            const int hd = u.pn & 3; const float l2g = __builtin_log2f(1.f - __builtin_exp2f(-5.f - (float)hd)) * (u.pn < 4 ? 1.f : -1.f);
#pragma unroll
            for (int ai = 0; ai < 2; ++ai)
#pragma unroll
                for (int m = 0; m < 4; ++m) { const int row = row0 + ai * HALF + m * 16; bf16_t* rowp = O + (size_t)row * ldc + u.pn * BM + d0;
                    const float dec = __builtin_amdgcn_exp2f(l2g * (float)(row & 127));
                    const f32x4 c0 = *(const f32x4*)(cs + (size_t)row * 128 + d0), c1 = *(const f32x4*)(cs + (size_t)row * 128 + d0 + 4);
                    const f32x4 s0 = *(const f32x4*)(sn + (size_t)row * 128 + d0), s1 = *(const f32x4*)(sn + (size_t)row * 128 + d0 + 4);
                    const f32x4 a0 = acc[ai][0][m][0], a1 = acc[ai][0][m][1], b0 = acc[ai][1][m][0], b1 = acc[ai][1][m][1];
                    *(u32x4*)rowp = pack8v((a0 * c0 - b0 * s0) * dec, (a1 * c1 - b1 * s1) * dec);
                    *(u32x4*)(rowp + HALF) = pack8v((a0 * s0 + b0 * c0) * dec, (a1 * s1 + b1 * c1) * dec); }
        } else {
            const bool gate = u.pn >= 16;
#pragma unroll
            for (int ai = 0; ai < 2; ++ai)
#pragma unroll
                for (int m = 0; m < 4; ++m) { bf16_t* rowp = O + (size_t)(row0 + ai * HALF + m * 16) * ldc + u.pn * BM + d0;
#pragma unroll
                    for (int bj = 0; bj < 2; ++bj) { f32x4 v0 = acc[ai][bj][m][0], v1 = acc[ai][bj][m][1];
                        if (gate) {
#pragma unroll
                            for (int j = 0; j < 4; ++j) { v0[j] = silu_fast(v0[j]); v1[j] = silu_fast(v1[j]); } }
                        *(u32x4*)(rowp + bj * HALF) = pack8v(v0, v1); } }
        }
    }
    __device__ __forceinline__ void fused(f32x4 (&acc)[2][2][4][2], const Unit& u, int wr, int wc, int fr, int fq, PG8_LAS unsigned char* lds, int wid, int lane) const {}
};
template <class Epi, class Sched, bool ALIGN_EPI = false, bool SP2 = false>
__device__ __forceinline__ void gemm_phase(PG8_LAS unsigned char* lds, const Gemm g, const Sched& S, const Epi& E) {
    const int tid = threadIdx.x, wid = __builtin_amdgcn_readfirstlane(tid >> 6), lane = tid & 63, wr = wid >> 2, wc = wid & 3, fr = lane & 15, fq = lane >> 4;
    const int K = g.K, nt = K / BK;
    unsigned voffA[2], voffB[2];
#pragma unroll
    for (int i = 0; i < 2; ++i) { int R, C; stage_rc(tid * 16 + i * 8192, R, C); const int Rb = Epi::PERM ? ((R & ~31) + perm32(R & 31)) : R;
        voffA[i] = (unsigned)(R * g.lda + C) * 2u; voffB[i] = (unsigned)(Rb * K + C) * 2u; }
    const size_t kstep = (size_t)(BK * 2);
    const size_t hstep = (size_t)HALF * K * 2;
    const size_t tstep = 2 * hstep, hstepA = (size_t)HALF * g.lda * 2, tstepA = 2 * hstepA;
    const unsigned ldsw = (unsigned)wid * 1024u;
    const int aoff = lds_byte(wr * 64 + fr, fq * 8), boff = lds_byte(wc * 32 + fr, fq * 8);
#define PG8_SA(b, h) (((b) * 2 + (h)) * HTB)
#define PG8_SB(b, h) ((4 + (b) * 2 + (h)) * HTB)
#define PG8_STAGE(bufoff, gbase, voff) do { _Pragma("unroll") for (int _i = 0; _i < 2; ++_i) \
        __builtin_amdgcn_global_load_lds((const unsigned*)((const char*)(gbase) + (voff)[_i]), (PG8_LAS unsigned*)(lds + (bufoff) + ldsw + _i * 8192), 16, 0, 0); } while (0)
#define PG8_LDA(dst, b, h) do { _Pragma("unroll") for (int m = 0; m < 4; ++m) _Pragma("unroll") for (int k = 0; k < 2; ++k) dst[m][k] = *(const PG8_LAS bf16x8*)(lds + PG8_SA(b, h) + aoff + m * 2048 + k * 1024); } while (0)
#define PG8_LDB(dst, b, h) do { _Pragma("unroll") for (int n = 0; n < 2; ++n) _Pragma("unroll") for (int k = 0; k < 2; ++k) dst[n][k] = *(const PG8_LAS bf16x8*)(lds + PG8_SB(b, h) + boff + n * 2048 + k * 1024); } while (0)
#define PG8_MMA(ai, bj, At, Bt) do { __builtin_amdgcn_s_setprio(1); _Pragma("unroll") for (int m = 0; m < 4; ++m) _Pragma("unroll") for (int n = 0; n < 2; ++n) _Pragma("unroll") for (int k = 0; k < 2; ++k) \
        acc[ai][bj][m][n] = __builtin_amdgcn_mfma_f32_16x16x32_bf16(Bt[n][k], At[m][k], acc[ai][bj][m][n], 0, 0, 0); __builtin_amdgcn_s_setprio(0); } while (0)
#define PG8_WAIT_V(n) asm volatile("s_waitcnt vmcnt(" #n ")" ::: "memory")
#define PG8_WAIT_L(n) asm volatile("s_waitcnt lgkmcnt(" #n ")" ::: "memory")
#define PG8_BAR __builtin_amdgcn_s_barrier()
#define PG8_SCHED __builtin_amdgcn_sched_barrier(0)
    Unit cur, nxt; int ui = 0;
    if (!S.next(0, cur)) return;
    f32x4 acc[2][2][4][2];
#pragma unroll
    for (int a = 0; a < 2; ++a)
#pragma unroll
        for (int b = 0; b < 2; ++b)
#pragma unroll
            for (int m = 0; m < 4; ++m)
#pragma unroll
                for (int n = 0; n < 2; ++n) acc[a][b][m][n] = (f32x4){0.f, 0.f, 0.f, 0.f};
    bf16x8 At[4][2], B0[2][2], B1[2][2];
    const char* cA = (const char*)g.A + (size_t)cur.pm * tstepA; const char* cB = (const char*)g.Bt + (size_t)cur.pn * tstep;
    S.a_ready(cur);
    if constexpr (SP2) {
        PG8_STAGE(PG8_SB(0, 0), cB, voffB); PG8_STAGE(PG8_SB(0, 1), cB + hstep, voffB); PG8_STAGE(PG8_SA(0, 0), cA, voffA); PG8_STAGE(PG8_SA(0, 1), cA + hstepA, voffA);
        if (wr == 1) PG8_BAR;
        PG8_WAIT_V(2); PG8_BAR;
        PG8_STAGE(PG8_SB(1, 0), cB + kstep, voffB); PG8_STAGE(PG8_SA(1, 0), cA + kstep, voffA); PG8_STAGE(PG8_SB(1, 1), cB + hstep + kstep, voffB);
        PG8_WAIT_V(6); PG8_BAR;
    } else {
        PG8_STAGE(PG8_SB(0, 0), cB, voffB); PG8_STAGE(PG8_SA(0, 0), cA, voffA); PG8_STAGE(PG8_SB(0, 1), cB + hstep, voffB); PG8_STAGE(PG8_SA(0, 1), cA + hstepA, voffA);
        if (wr == 1) PG8_BAR;
        PG8_WAIT_V(4); PG8_BAR;
        PG8_STAGE(PG8_SB(1, 0), cB + kstep, voffB); PG8_STAGE(PG8_SA(1, 0), cA + kstep, voffA); PG8_STAGE(PG8_SB(1, 1), cB + hstep + kstep, voffB);
        PG8_WAIT_V(6); PG8_BAR;
    }
    for (;;) {
        const bool has_next = S.next(ui + 1, nxt);
        const char* nA = has_next ? (const char*)g.A + (size_t)nxt.pm * tstepA : cA; const char* nB = has_next ? (const char*)g.Bt + (size_t)nxt.pn * tstep : cB;
        for (int t = 0; t < nt; t += 2) {
            const bool last = (t == nt - 2);
            const char* a1 = cA + (size_t)(t + 1) * kstep;
            const char* a2 = last ? nA : cA + (size_t)(t + 2) * kstep; const char* b2 = last ? nB : cB + (size_t)(t + 2) * kstep;
            const char* a3 = a2 + kstep; const char* b3 = b2 + kstep;
            if (last && has_next) S.a_ready(nxt);
            if constexpr (SP2) {
            PG8_LDB(B0, 0, 0); PG8_LDB(B1, 0, 1); PG8_SCHED; PG8_LDA(At, 0, 0); PG8_STAGE(PG8_SA(1, 1), a1 + hstepA, voffA);
            PG8_WAIT_V(8); PG8_WAIT_L(0); PG8_BAR; PG8_MMA(0, 0, At, B0); PG8_MMA(0, 1, At, B1); PG8_BAR; PG8_SCHED;
            PG8_LDA(At, 0, 1); PG8_STAGE(PG8_SB(0, 0), b2, voffB); PG8_STAGE(PG8_SB(0, 1), b2 + hstep, voffB); PG8_STAGE(PG8_SA(0, 0), a2, voffA);
            PG8_WAIT_V(8); PG8_WAIT_L(0); PG8_BAR; PG8_MMA(1, 0, At, B0); PG8_MMA(1, 1, At, B1); PG8_BAR; PG8_SCHED;
            PG8_LDB(B0, 1, 0); PG8_LDB(B1, 1, 1); PG8_SCHED; PG8_LDA(At, 1, 0); PG8_STAGE(PG8_SA(0, 1), a2 + hstepA, voffA);
            PG8_WAIT_V(8); PG8_WAIT_L(0); PG8_BAR; PG8_MMA(0, 0, At, B0); PG8_MMA(0, 1, At, B1); PG8_BAR; PG8_SCHED;
            PG8_LDA(At, 1, 1); PG8_STAGE(PG8_SB(1, 0), b3, voffB); PG8_STAGE(PG8_SB(1, 1), b3 + hstep, voffB); PG8_STAGE(PG8_SA(1, 0), a3, voffA);
            PG8_WAIT_V(8); PG8_WAIT_L(0); PG8_BAR; PG8_MMA(1, 0, At, B0); PG8_MMA(1, 1, At, B1); PG8_BAR; PG8_SCHED;
            } else {
            PG8_LDB(B0, 0, 0); PG8_SCHED; PG8_LDA(At, 0, 0); PG8_STAGE(PG8_SA(1, 1), a1 + hstepA, voffA);
            PG8_WAIT_L(8); PG8_BAR; PG8_WAIT_L(0); PG8_MMA(0, 0, At, B0); PG8_BAR; PG8_SCHED;
            PG8_LDB(B1, 0, 1); PG8_STAGE(PG8_SB(0, 0), b2, voffB);
            PG8_BAR; PG8_WAIT_L(0); PG8_MMA(0, 1, At, B1); PG8_BAR;
            PG8_LDA(At, 0, 1); PG8_STAGE(PG8_SA(0, 0), a2, voffA);
            PG8_BAR; PG8_WAIT_L(0); PG8_MMA(1, 0, At, B0); PG8_BAR; PG8_SCHED;
            PG8_STAGE(PG8_SB(0, 1), b2 + hstep, voffB);
            PG8_WAIT_V(6); PG8_BAR; PG8_MMA(1, 1, At, B1); PG8_BAR;
            PG8_LDB(B0, 1, 0); PG8_SCHED; PG8_LDA(At, 1, 0); PG8_STAGE(PG8_SA(0, 1), a2 + hstepA, voffA);
            PG8_WAIT_L(8); PG8_BAR; PG8_WAIT_L(0); PG8_MMA(0, 0, At, B0); PG8_BAR; PG8_SCHED;
            PG8_LDB(B1, 1, 1); PG8_STAGE(PG8_SB(1, 0), b3, voffB);
            PG8_BAR; PG8_WAIT_L(0); PG8_MMA(0, 1, At, B1); PG8_BAR;
            PG8_LDA(At, 1, 1); PG8_STAGE(PG8_SA(1, 0), a3, voffA);
            PG8_BAR; PG8_WAIT_L(0); PG8_MMA(1, 0, At, B0); PG8_BAR; PG8_SCHED;
            PG8_STAGE(PG8_SB(1, 1), b3 + hstep, voffB);
            PG8_WAIT_V(6); PG8_BAR; PG8_MMA(1, 1, At, B1); PG8_BAR;
            }
        }
        if constexpr (ALIGN_EPI) { if (wr == 0) PG8_BAR; }
        if constexpr (!Epi::AFTER_DRAIN) { E(acc, cur, wr, wc, fr, fq); S.done(cur); }
        if (!has_next) break;
#pragma unroll
        for (int a = 0; a < 2; ++a)
#pragma unroll
            for (int b = 0; b < 2; ++b)
#pragma unroll
                for (int m = 0; m < 4; ++m)
#pragma unroll
                    for (int n = 0; n < 2; ++n) acc[a][b][m][n] = (f32x4){0.f, 0.f, 0.f, 0.f};
        cur = nxt; cA = nA; cB = nB; ++ui;
        if constexpr (ALIGN_EPI) { if (wr == 1) PG8_BAR; }
    }
    PG8_WAIT_V(0);
    if constexpr (!ALIGN_EPI) { if (wr == 0) PG8_BAR; }
    PG8_BAR;
    if constexpr (Epi::AFTER_DRAIN) { E.fused(acc, cur, wr, wc, fr, fq, lds, wid, lane); S.done(cur); }
#undef PG8_SA
#undef PG8_SB
#undef PG8_STAGE
#undef PG8_LDA
#undef PG8_LDB
#undef PG8_MMA
#undef PG8_WAIT_V
#undef PG8_WAIT_L
#undef PG8_BAR
#undef PG8_SCHED
}
}
namespace sba {
typedef short bf16x8 __attribute__((ext_vector_type(8)));
typedef short s16x4 __attribute__((ext_vector_type(4)));
typedef float f32x16 __attribute__((ext_vector_type(16)));
typedef unsigned u32x4 __attribute__((ext_vector_type(4)));
constexpr int KVBLK = 64, SHM_V = KVBLK * 128 * 2, SHM_K = KVBLK * 128 * 2;
constexpr int LDS_V = 0, LDS_K = 2 * SHM_V, LDS_FLAG = 2 * SHM_V + 2 * SHM_K;
#define SB_KSWZ(row, colB) ((row) * 256 + ((colB) ^ (((row) & 7) << 4)))
__device__ __forceinline__ int v_st(int k, int c) { const int kk = (k & ~0xC) | ((k & 4) << 1) | ((k & 8) >> 1); return ((kk >> 3) * 4 + (c >> 5)) * 512 + ((kk & 7) * 32 + (c & 31)) * 2; }
__device__ __forceinline__ int v_rd_base(int lane) { return ((lane & 3) << 3) | (((lane >> 2) & 3) << 6) | (((lane >> 4) & 1) << 5) | (((lane >> 5) & 1) << 8); }
constexpr int v_rd_off(int d0, int ks, int half) { return d0 * 512 + ks * 4096 + half * 2048; }
__device__ __forceinline__ int crow(int r, int hi) { return (r & 3) + 8 * (r >> 2) + 4 * hi; }
__device__ __forceinline__ unsigned cvtpk(float lo, float hi) { unsigned r; asm volatile("v_cvt_pk_bf16_f32 %0, %1, %2" : "=v"(r) : "v"(lo), "v"(hi)); return r; }
#define SB_SBAR() __builtin_amdgcn_sched_barrier(0)
template <int KB>
__device__ __forceinline__ void qkt(f32x16& p0, f32x16& p1, LAS const unsigned char* K_lds, int r32, int hi, const bf16x8* qr) {
    p0 = f32x16{}; p1 = f32x16{};
    LAS const unsigned char* kb[4];
#pragma unroll
    for (int dd = 0; dd < 4; ++dd) kb[dd] = K_lds + KB * SHM_K + SB_KSWZ(r32, (dd * 16 + hi * 8) * 2);
#pragma unroll
    for (int d0 = 0; d0 < 8; ++d0) { LAS const unsigned char* a = kb[d0 & 3] + (d0 >> 2) * 128;
        const bf16x8 b0 = *(LAS const bf16x8*)a;
        const bf16x8 b1 = *(LAS const bf16x8*)(a + 32 * 256);
        p0 = __builtin_amdgcn_mfma_f32_32x32x16_bf16(b0, qr[d0], p0, 0, 0, 0);
        p1 = __builtin_amdgcn_mfma_f32_32x32x16_bf16(b1, qr[d0], p1, 0, 0, 0); }
}
template <int VB>
__device__ __forceinline__ void pv_tile(f32x16* o, int vb0, bf16x8 pa0, bf16x8 pa1, bf16x8 pa2, bf16x8 pa3) {
#define SB_TRRD(dst, off) asm volatile("ds_read_b64_tr_b16 %0, %1 offset:%2" : "=&v"(dst) : "v"(vb0), "i"(off) : "memory")
#define SB_PV_D0(d0) do { s16x4 l0, l1, l2, l3, h0, h1, h2, h3; constexpr int b_ = VB * SHM_V + v_rd_off(d0, 0, 0); \
        SB_TRRD(l0, b_); SB_TRRD(h0, b_ + 2048); SB_TRRD(l1, b_ + 4096); SB_TRRD(h1, b_ + 6144); SB_TRRD(l2, b_ + 8192); SB_TRRD(h2, b_ + 10240); SB_TRRD(l3, b_ + 12288); SB_TRRD(h3, b_ + 14336); \
        asm volatile("s_waitcnt lgkmcnt(0)" ::: "memory"); SB_SBAR(); \
        o[d0] = __builtin_amdgcn_mfma_f32_32x32x16_bf16(pa0, (bf16x8){l0[0], l0[1], l0[2], l0[3], h0[0], h0[1], h0[2], h0[3]}, o[d0], 0, 0, 0); \
        o[d0] = __builtin_amdgcn_mfma_f32_32x32x16_bf16(pa1, (bf16x8){l1[0], l1[1], l1[2], l1[3], h1[0], h1[1], h1[2], h1[3]}, o[d0], 0, 0, 0); \
        o[d0] = __builtin_amdgcn_mfma_f32_32x32x16_bf16(pa2, (bf16x8){l2[0], l2[1], l2[2], l2[3], h2[0], h2[1], h2[2], h2[3]}, o[d0], 0, 0, 0); \
        o[d0] = __builtin_amdgcn_mfma_f32_32x32x16_bf16(pa3, (bf16x8){l3[0], l3[1], l3[2], l3[3], h3[0], h3[1], h3[2], h3[3]}, o[d0], 0, 0, 0); } while (0)
    SB_PV_D0(0); SB_PV_D0(1); SB_PV_D0(2); SB_PV_D0(3);
#undef SB_PV_D0
#undef SB_TRRD
}
__device__ __forceinline__ float swap_pick(float a, float b, int hi) {
    auto rr = __builtin_amdgcn_permlane32_swap(__float_as_uint(a), __float_as_uint(b), false, false);
    return __uint_as_float(hi ? rr[0] : rr[1]);
}
__device__ __forceinline__ void sb_half(f32x16& p, float& R, int hi, bool need_mask, int dq, bf16x8& paA, bf16x8& paB) {
    f32x16 s;
#pragma unroll
    for (int r = 0; r < 16; ++r) s[r] = fmaxf(p[r], 0.f) + __builtin_amdgcn_logf(1.f + __builtin_amdgcn_exp2f(-__builtin_fabsf(p[r])));
    if (need_mask) { const float NEG = -__builtin_inff();
#pragma unroll
        for (int r = 0; r < 16; ++r) { const int c = (r & 3) + 8 * (r >> 2); if (!(c < dq)) { s[r] = 0.f; p[r] = NEG; } } }
    float LS[5];
    LS[4] = 0.f;
#pragma unroll
    for (int k = 3; k >= 0; --k) LS[k] = LS[k + 1] + ((s[4 * k] + s[4 * k + 1]) + (s[4 * k + 2] + s[4 * k + 3]));
    const float tot = LS[0] + swap_pick(LS[0], LS[0], hi);
#pragma unroll
    for (int k = 0; k < 4; ++k) {
        const float e3 = R - LS[k + 1] - swap_pick(LS[k], LS[k + 1], hi);
        const float e2 = e3 - s[4 * k + 3], e1 = e2 - s[4 * k + 2], e0 = e1 - s[4 * k + 1];
        p[4 * k + 3] = __builtin_amdgcn_exp2f(p[4 * k + 3] - s[4 * k + 3] + e3); p[4 * k + 2] = __builtin_amdgcn_exp2f(p[4 * k + 2] - s[4 * k + 2] + e2);
        p[4 * k + 1] = __builtin_amdgcn_exp2f(p[4 * k + 1] - s[4 * k + 1] + e1); p[4 * k + 0] = __builtin_amdgcn_exp2f(p[4 * k + 0] - s[4 * k + 0] + e0);
    }
    R -= tot;
#define SB_PK4(P, B_, OUT) do { unsigned a0 = cvtpk(P[B_+0], P[B_+1]), a1 = cvtpk(P[B_+2], P[B_+3]); unsigned b0 = cvtpk(P[B_+4], P[B_+5]), b1 = cvtpk(P[B_+6], P[B_+7]); \
        auto r0 = __builtin_amdgcn_permlane32_swap(a0, b0, false, false); auto r1 = __builtin_amdgcn_permlane32_swap(a1, b1, false, false); \
        u32x4 w = {r0[0], r1[0], r0[1], r1[1]}; OUT = *reinterpret_cast<bf16x8*>(&w); } while (0)
    SB_PK4(p, 0, paA); SB_PK4(p, 8, paB);
#undef SB_PK4
}
__device__ __forceinline__ void sb_tile(f32x16& p0, f32x16& p1, float& R, int hi, bool need_mask, int dq, bf16x8& pa0, bf16x8& pa1, bf16x8& pa2, bf16x8& pa3) {
    sb_half(p1, R, hi, need_mask, dq - 32, pa2, pa3);
    sb_half(p0, R, hi, need_mask, dq, pa0, pa1);
}
__device__ __forceinline__ void sb_block(const bf16* Qh, const bf16* Kh, const bf16* Vh, int ld, bf16* Oh, int ldo, int qb, LAS unsigned char* lds) {
    const int tid = threadIdx.x, wid = __builtin_amdgcn_readfirstlane(tid >> 6), lane = tid & 63, r32 = lane & 31, hi = lane >> 5;
    const int NT = 4 * (qb + 1);
    const int qlo = 256 * qb + 32 * wid, qm = qlo + r32 - 4 * hi;
    LAS unsigned char* V_lds = lds + LDS_V; LAS unsigned char* K_lds = lds + LDS_K; volatile LAS unsigned* flags = (volatile LAS unsigned*)(lds + LDS_FLAG);
    bf16x8 qr[8];
#pragma unroll
    for (int d0 = 0; d0 < 8; ++d0) qr[d0] = *(const bf16x8*)(Qh + (size_t)(qlo + r32) * ld + d0 * 16 + hi * 8);
    const int sr = tid >> 4, sc = (tid & 15) * 8, vst0 = v_st(sr, sc), vst1 = v_st(32 + sr, sc), kws = SB_KSWZ(sr, sc * 2);
    const int vb0 = (int)(unsigned)(size_t)V_lds + v_rd_base(lane);
    float R = 0.f; f32x16 o[4] = {}; bool done = false;
    bf16x8 st_k0, st_k1, st_v0, st_v1;
#define SB_LOAD(kb_) do { st_k0 = *(const bf16x8*)(Kh + (size_t)((kb_) + sr) * ld + sc); st_k1 = *(const bf16x8*)(Kh + (size_t)((kb_) + 32 + sr) * ld + sc); \
                          st_v0 = *(const bf16x8*)(Vh + (size_t)((kb_) + sr) * ld + sc); st_v1 = *(const bf16x8*)(Vh + (size_t)((kb_) + 32 + sr) * ld + sc); } while (0)
#define SB_WRITE(bf) do { *(LAS bf16x8*)(K_lds + (bf) * SHM_K + kws) = st_k0; *(LAS bf16x8*)(K_lds + (bf) * SHM_K + kws + 32 * 256) = st_k1; \
                          *(LAS bf16x8*)(V_lds + (bf) * SHM_V + vst0) = st_v0; *(LAS bf16x8*)(V_lds + (bf) * SHM_V + vst1) = st_v1; } while (0)
    SB_LOAD((NT - 1) * KVBLK); asm volatile("s_waitcnt vmcnt(0)" ::: "memory"); SB_WRITE(0);
    __syncthreads();
    bool all_done = false;
#define SB_STEP(t_, BUF) do { const int kb_ = (NT - 1 - (t_)) * KVBLK; \
        if ((t_) + 1 < NT) SB_LOAD(kb_ - KVBLK); \
        if (!done && kb_ < qlo + 31) { f32x16 p0, p1; bf16x8 pa0, pa1, pa2, pa3; \
            qkt<BUF>(p0, p1, K_lds, r32, hi, qr); \
            sb_tile(p0, p1, R, hi, kb_ + KVBLK - 1 >= qlo, qm - kb_, pa0, pa1, pa2, pa3); SB_SBAR(); \
            pv_tile<BUF>(o, vb0, pa0, pa1, pa2, pa3); \
            done = __all(R < -160.f); } \
        if ((t_) + 1 < NT) { asm volatile("s_waitcnt vmcnt(0)" ::: "memory"); SB_WRITE((BUF) ^ 1); } \
        if (lane == 0) flags[wid] = done ? 1u : 0u; \
        __syncthreads(); \
        { unsigned f_ = 1u; _Pragma("unroll") for (int w_ = 0; w_ < 8; ++w_) f_ &= flags[w_]; all_done = f_ != 0u; } \
        __syncthreads(); } while (0)
    for (int t = 0; t < NT; t += 2) { SB_STEP(t, 0); if (all_done) break; SB_STEP(t + 1, 1); if (all_done) break; }
#undef SB_STEP
#undef SB_LOAD
#undef SB_WRITE
    bf16* Ow = Oh + (size_t)qlo * ldo;
#pragma unroll
    for (int r = 0; r < 16; ++r) { const int orow = crow(r, hi);
#pragma unroll
        for (int d0 = 0; d0 < 4; ++d0) { const float v = o[d0][r]; const float vn = __shfl_xor(v, 1);
            if ((r32 & 1) == 0) *(unsigned*)(Ow + (size_t)orow * ldo + d0 * 32 + r32) = cvtpk(v, vn); } }
}
__device__ __forceinline__ void sb_phase(const bf16* QKV, bf16* AO, LAS unsigned char* lds, int G, int bx) {
    const int vcu = (G % 8 == 0) ? (bx % 8) * (G / 8) + bx / 8 : bx;
    for (int item = vcu; item < BATCH * SH * 8; item += G) {
        const int bh = item >> 3, y = item & 7, b = bh >> 3, h = bh & 7;
        const bf16* base = QKV + (size_t)b * SEQ * SIN + h * 128; bf16* ob = AO + (size_t)b * SEQ * SW + h * 128;
        sb_block(base, base + SW, base + 2 * SW, SIN, ob, SW, 15 - y, lds);
        sb_block(base, base + SW, base + 2 * SW, SIN, ob, SW, y, lds);
    }
}
}
namespace ret {
typedef short bf16x8 __attribute__((ext_vector_type(8)));
typedef short s16x4 __attribute__((ext_vector_type(4)));
typedef float f32x16 __attribute__((ext_vector_type(16)));
typedef unsigned u32x4 __attribute__((ext_vector_type(4)));
#define RT_TRRD(dst, addr, off) asm volatile("ds_read_b64_tr_b16 %0, %1 offset:%2" : "=&v"(dst) : "v"(addr), "i"(off) : "memory")
#define RT_CAT(l, h) ((bf16x8){l[0], l[1], l[2], l[3], h[0], h[1], h[2], h[3]})
__device__ __forceinline__ void scan_phase(const bf16* QKVG, bf16* ST, LAS unsigned char* lds, int G, int bx) {
    const int tid = threadIdx.x, wid = __builtin_amdgcn_readfirstlane(tid >> 6), lane = tid & 63, r32 = lane & 31, hi = lane >> 5;
    LAS unsigned char* Kl = lds + wid * 16384; LAS unsigned char* Vl = Kl + 8192;
    const int trb = (8 * hi + ((lane >> 2) & 3)) * 64 + (16 * ((lane >> 4) & 1) + 4 * (lane & 3)) * 2;
    const int ka = (int)(unsigned)(size_t)Kl + trb, va = (int)(unsigned)(size_t)Vl + trb;
    for (int item = bx; item < BATCH * RH * 16; item += G) {
        const int b = item >> 6, h = (item >> 4) & 3, sl = item & 15;
        const float l2g = __builtin_log2f(1.f - __builtin_exp2f(-5.f - (float)h));
        const float gam = __builtin_exp2f(l2g), g128 = __builtin_exp2f(128.f * l2g), g127 = __builtin_exp2f(127.f * l2g);
        const bf16* Kb = QKVG + (size_t)b * SEQ * RIN + RQK + h * RDK + 32 * wid;
        const bf16* Vb = QKVG + (size_t)b * SEQ * RIN + 2 * RQK + h * RDV + sl * 32;
        f32x16 st = {};
        bf16x8 kreg[8], vreg[8];
#define RT_LOADC(c_) do { _Pragma("unroll") for (int i = 0; i < 8; ++i) { const int id = i * 64 + lane, row = id >> 2, ch = id & 3; \
            kreg[i] = *(const bf16x8*)(Kb + (size_t)((c_) * 128 + row) * RIN + ch * 8); vreg[i] = *(const bf16x8*)(Vb + (size_t)((c_) * 128 + row) * RIN + ch * 8); } } while (0)
        RT_LOADC(0);
        for (int c = 0; c < 32; ++c) {
            {
                bf16* sp = ST + ((size_t)(((b * RH + h) * 32 + c) * 32 + 4 * wid) * RDV + sl * 32 + r32) * 8 + 4 * hi;
#pragma unroll
                for (int g = 0; g < 4; ++g) { uint2 w; w.x = sba::cvtpk(st[4 * g] * gam, st[4 * g + 1] * gam); w.y = sba::cvtpk(st[4 * g + 2] * gam, st[4 * g + 3] * gam);
                    *(uint2*)(sp + (size_t)g * RDV * 8) = w; }
            }
            if (c == 31) break;
#pragma unroll
            for (int i = 0; i < 8; ++i) { *(LAS bf16x8*)(Kl + (i * 64 + lane) * 16) = kreg[i]; *(LAS bf16x8*)(Vl + (i * 64 + lane) * 16) = vreg[i]; }
            asm volatile("s_waitcnt lgkmcnt(0)" ::: "memory");
            if (c + 1 < 31) RT_LOADC(c + 1);
            f32x16 acc = {};
#pragma unroll
            for (int s = 0; s < 8; ++s) { s16x4 a0, a1, b0, b1;
                RT_TRRD(a0, ka, s * 1024); RT_TRRD(a1, ka, s * 1024 + 256); RT_TRRD(b0, va, s * 1024); RT_TRRD(b1, va, s * 1024 + 256);
                asm volatile("s_waitcnt lgkmcnt(0)" ::: "memory"); __builtin_amdgcn_sched_barrier(0);
                acc = __builtin_amdgcn_mfma_f32_32x32x16_bf16(RT_CAT(a0, a1), RT_CAT(b0, b1), acc, 0, 0, 0); }
#pragma unroll
            for (int r = 0; r < 16; ++r) st[r] = g128 * st[r] + g127 * acc[r];
        }
#undef RT_LOADC
    }
}
constexpr int RO_K = 0, RO_V = 32768, RO_VROW = 1088, RO_T = 32768 + 64 * RO_VROW;
__device__ __forceinline__ void out_phase(bf16* QKVG, const bf16* ST, const float* gn, LAS unsigned char* lds, int G, int bx) {
    const int tid = threadIdx.x, wid = __builtin_amdgcn_readfirstlane(tid >> 6), lane = tid & 63, r32 = lane & 31, hi = lane >> 5;
    const int rb = wid & 3, dvh = wid >> 2;
    LAS unsigned char* Kl = lds + RO_K; LAS unsigned char* Vl = lds + RO_V; LAS float* Tt = (LAS float*)(lds + RO_T);
    const int sr = tid >> 4, sc = (tid & 15) * 8, kws = SB_KSWZ(sr, sc * 2);
    const int va = (int)(unsigned)(size_t)Vl + (4 * hi + ((lane >> 2) & 3)) * RO_VROW + (256 * dvh + 16 * ((lane >> 4) & 1) + 4 * (lane & 3)) * 2;
    for (int unit = bx; unit < BATCH * RH * 32; unit += G) {
        const int bh = unit >> 5, c = unit & 31, b = bh >> 2, h = bh & 3;
        const size_t row0 = (size_t)b * SEQ + c * 128;
        const bf16* Qb = QKVG + row0 * RIN + h * RDK; const bf16* Kb = Qb + RQK; const bf16* Vb = QKVG + row0 * RIN + 2 * RQK + h * RDV; bf16* Gb = QKVG + row0 * RIN + 2 * RQK + RV + h * RDV;
        const bf16* qrow = Qb + (size_t)(32 * rb + r32) * RIN + hi * 8;
        f32x16 o[8];
#pragma unroll
        for (int d = 0; d < 8; ++d) o[d] = f32x16{};
#pragma unroll
        for (int kt = 0; kt < 2; ++kt) {
            __syncthreads();
            { bf16x8 kr[4], vr[8];
#pragma unroll
              for (int q = 0; q < 4; ++q) kr[q] = *(const bf16x8*)(Kb + (size_t)(64 * kt + sr + 32 * (q & 1)) * RIN + (q >> 1) * 128 + sc);
#pragma unroll
              for (int q = 0; q < 8; ++q) vr[q] = *(const bf16x8*)(Vb + (size_t)(64 * kt + sr + 32 * (q & 1)) * RIN + (q >> 1) * 128 + sc);
#pragma unroll
              for (int q = 0; q < 4; ++q) *(LAS bf16x8*)(Kl + (q >> 1) * 16384 + kws + (q & 1) * 32 * 256) = kr[q];
#pragma unroll
              for (int q = 0; q < 8; ++q) *(LAS bf16x8*)(Vl + (sr + 32 * (q & 1)) * RO_VROW + ((q >> 1) * 128 + sc) * 2) = vr[q]; }
            __syncthreads();
            if (64 * kt <= 32 * rb + 31) {
                f32x16 p0 = {}, p1 = {};
#pragma unroll
                for (int half = 0; half < 2; ++half) {
                    LAS const unsigned char* kb4[4];
#pragma unroll
                    for (int dd = 0; dd < 4; ++dd) kb4[dd] = Kl + half * 16384 + SB_KSWZ(r32, (dd * 16 + hi * 8) * 2);
#pragma unroll
                    for (int d0 = 0; d0 < 8; ++d0) { LAS const unsigned char* a = kb4[d0 & 3] + (d0 >> 2) * 128;
                        const bf16x8 qf = *(const bf16x8*)(qrow + half * 128 + d0 * 16);
                        p0 = __builtin_amdgcn_mfma_f32_32x32x16_bf16(*(LAS const bf16x8*)a, qf, p0, 0, 0, 0);
                        p1 = __builtin_amdgcn_mfma_f32_32x32x16_bf16(*(LAS const bf16x8*)(a + 32 * 256), qf, p1, 0, 0, 0); } }
                if (64 * kt + 63 > 32 * rb) { const int dq = 32 * rb + r32 - 64 * kt - 4 * hi + 1;
#pragma unroll
                    for (int r = 0; r < 16; ++r) { const int cc = (r & 3) + 8 * (r >> 2); if (!(cc < dq)) p0[r] = 0.f; if (!(cc + 32 < dq)) p1[r] = 0.f; } }
#pragma unroll
                for (int ph = 0; ph < 2; ++ph)
#pragma unroll
                    for (int s2 = 0; s2 < 2; ++s2) {
                        u32x4 w; const f32x16& pp = ph ? p1 : p0;
                        w.x = sba::cvtpk(pp[8 * s2 + 0], pp[8 * s2 + 1]); w.y = sba::cvtpk(pp[8 * s2 + 2], pp[8 * s2 + 3]); w.z = sba::cvtpk(pp[8 * s2 + 4], pp[8 * s2 + 5]); w.w = sba::cvtpk(pp[8 * s2 + 6], pp[8 * s2 + 7]);
                        const bf16x8 pb = *reinterpret_cast<bf16x8*>(&w);
#pragma unroll
                        for (int d = 0; d < 8; ++d) { s16x4 a0, a1;
                            RT_TRRD(a0, va, (32 * ph + 16 * s2) * RO_VROW + d * 64); RT_TRRD(a1, va, (32 * ph + 16 * s2 + 8) * RO_VROW + d * 64);
                            asm volatile("s_waitcnt lgkmcnt(0)" ::: "memory"); __builtin_amdgcn_sched_barrier(0);
                            o[d] = __builtin_amdgcn_mfma_f32_32x32x16_bf16(RT_CAT(a0, a1), pb, o[d], 0, 0, 0); }
                    }
            }
        }
        { const bf16* sp = ST + ((size_t)((bh * 32 + c) * 32 + hi) * RDV + 256 * dvh + r32) * 8;
#pragma unroll 2
          for (int s = 0; s < 16; ++s) { const bf16x8 qf = *(const bf16x8*)(qrow + s * 16);
#pragma unroll
              for (int d = 0; d < 8; ++d) { const bf16x8 af = *(const bf16x8*)(sp + ((size_t)(2 * s) * RDV + 32 * d) * 8);
                  o[d] = __builtin_amdgcn_mfma_f32_32x32x16_bf16(af, qf, o[d], 0, 0, 0); } } }
        float s1 = 0.f, s2 = 0.f;
#pragma unroll
        for (int d = 0; d < 8; ++d)
#pragma unroll
            for (int r = 0; r < 16; ++r) { s1 += o[d][r]; s2 += o[d][r] * o[d][r]; }
        s1 += sba::swap_pick(s1, s1, hi); s2 += sba::swap_pick(s2, s2, hi);
        __syncthreads();
        if (hi == 0) { Tt[(dvh * 128 + 32 * rb + r32) * 2] = s1; Tt[(dvh * 128 + 32 * rb + r32) * 2 + 1] = s2; }
        __syncthreads();
        const float t1 = Tt[(32 * rb + r32) * 2] + Tt[(128 + 32 * rb + r32) * 2], t2 = Tt[(32 * rb + r32) * 2 + 1] + Tt[(128 + 32 * rb + r32) * 2 + 1];
        const float mu = t1 * (1.f / 512.f), rstd = rsqrtf(fmaxf(t2 * (1.f / 512.f) - mu * mu, 0.f) + GN_EPS);
        bf16* grow = Gb + (size_t)(32 * rb + r32) * RIN + 256 * dvh + 4 * hi;
        const float* gnp = gn + h * RDV + 256 * dvh + 4 * hi;
#pragma unroll
        for (int d = 0; d < 8; ++d)
#pragma unroll
            for (int g = 0; g < 4; ++g) { const uint2 sg = *(const uint2*)(grow + 32 * d + 8 * g); const f32x4 gv = *(const f32x4*)(gnp + 32 * d + 8 * g);
                const float v0 = (o[d][4 * g] - mu) * rstd * gv[0] * __builtin_bit_cast(float, sg.x << 16), v1 = (o[d][4 * g + 1] - mu) * rstd * gv[1] * __builtin_bit_cast(float, sg.x & 0xffff0000u);
                const float v2 = (o[d][4 * g + 2] - mu) * rstd * gv[2] * __builtin_bit_cast(float, sg.y << 16), v3 = (o[d][4 * g + 3] - mu) * rstd * gv[3] * __builtin_bit_cast(float, sg.y & 0xffff0000u);
                uint2 w; w.x = sba::cvtpk(v0, v1); w.y = sba::cvtpk(v2, v3); *(uint2*)(grow + 32 * d + 8 * g) = w; }
    }
}
#undef RT_TRRD
#undef RT_CAT
}
constexpr int NWAVES = 8, NTHR = 512;
constexpr int LDS_MISC = 131072;
constexpr int LDS_BYTES = 147456;
constexpr size_t MiB = 1u << 20;
constexpr size_t WS_CTL = 0, CTL_BYTES = 1 * MiB, CTL_ZERO_BYTES = 16384;
constexpr size_t WS_XN = 1 * MiB;
constexpr size_t WS_WFFN = WS_XN + (size_t)M * D * 2;
constexpr size_t WS_WMIX = WS_WFFN + (size_t)3 * D * FF * 2;
constexpr size_t WS_WPLE = WS_WMIX + (size_t)(RIN * D + RV * D) * 2;
constexpr size_t WS_PB = WS_WPLE + (size_t)(D * D + D * PLE) * 2;
constexpr size_t WS_ROPE = WS_PB + (size_t)M * PLE * 2;
constexpr size_t WS_BIG = WS_ROPE + (size_t)M * 128 * 4 * 2;
constexpr size_t WS_ST = WS_BIG + (size_t)M * RIN * 2;
constexpr size_t WS_END = WS_ST + (size_t)BATCH * RH * 32 * RDK * RDV * 2;
static_assert(WS_XN % 256 == 0 && WS_WFFN % 256 == 0 && WS_WMIX % 256 == 0 && WS_WPLE % 256 == 0 && WS_PB % 256 == 0 && WS_ROPE % 256 == 0 && WS_BIG % 256 == 0 && WS_ST % 256 == 0, "alignment");

struct Params { const float* in[14]; float* out; unsigned char* ws; int ph_lo, ph_hi; };

__device__ __forceinline__ float wave_sum(float v) {
#pragma unroll
    for (int o = 1; o < 64; o <<= 1) v += __shfl_xor(v, o);
    return v;
}
struct ConvJob { const float* W; bf16* WT; int K, N, grp, gstride, goff, s_lo, s_hi; float sc; };
__device__ __forceinline__ void transpose_item(const ConvJob& j, LAS float* scr, int k0, int n0, int lane) {
    const int dst_row0 = (n0 / j.grp) * j.gstride + j.goff + n0 % j.grp; const float sc = (n0 >= j.s_lo && n0 < j.s_hi) ? j.sc : 1.f;
#pragma unroll 8
    for (int i = 0; i < 32; ++i) { const int kk = 2 * i + (lane >> 5); scr[kk * 33 + (lane & 31)] = j.W[(size_t)(k0 + kk) * j.N + n0 + (lane & 31)]; }
    asm volatile("s_waitcnt lgkmcnt(0)" ::: "memory");
    const int c = lane & 7;
#pragma unroll
    for (int q = 0; q < 4; ++q) { const int n = (lane >> 3) + 8 * q; const LAS float* s = scr + (8 * c) * 33 + n;
        v4u o; o.x = pk2(s[0 * 33] * sc, s[1 * 33] * sc); o.y = pk2(s[2 * 33] * sc, s[3 * 33] * sc); o.z = pk2(s[4 * 33] * sc, s[5 * 33] * sc); o.w = pk2(s[6 * 33] * sc, s[7 * 33] * sc);
        *(v4u*)(j.WT + (size_t)(dst_row0 + n) * j.K + k0 + 8 * c) = o; }
    asm volatile("s_waitcnt lgkmcnt(0)" ::: "memory");
}
__device__ __forceinline__ void convert_job(const ConvJob& j, LAS float* scr, int gw, int ngw, int lane) {
    const int nblk = j.N / 32, nitems = (j.K / 64) * nblk;
    for (int it = gw; it < nitems; it += ngw) { const int kb = it / nblk, nb = it % nblk; transpose_item(j, scr, kb * 64, nb * 32, lane); }
}
__device__ __forceinline__ void thin_rows(const float* hin, float* hout, const float* F, const float* gpost, float w, const float* gpre, bf16* XN, int gw, int ngw, int lane) {
    f32x4 gp[4], gq[4];
#pragma unroll
    for (int j = 0; j < 4; ++j) { gp[j] = F ? *(const f32x4*)(gpost + 4 * lane + 256 * j) : (f32x4){0.f, 0.f, 0.f, 0.f}; gq[j] = XN ? *(const f32x4*)(gpre + 4 * lane + 256 * j) : (f32x4){0.f, 0.f, 0.f, 0.f}; }
    for (int m = gw; m < M; m += ngw) {
        f32x4 hv[4];
#pragma unroll
        for (int j = 0; j < 4; ++j) hv[j] = *(const f32x4*)(hin + (size_t)m * D + 4 * lane + 256 * j);
        if (F) { f32x4 fv[4]; float s = 0.f;
#pragma unroll
            for (int j = 0; j < 4; ++j) { fv[j] = *(const f32x4*)(F + (size_t)m * D + 4 * lane + 256 * j); s += (fv[j][0] * fv[j][0] + fv[j][1] * fv[j][1]) + (fv[j][2] * fv[j][2] + fv[j][3] * fv[j][3]); }
            const float r = w * rsqrtf(wave_sum(s) * (1.f / D) + RMS_EPS);
#pragma unroll
            for (int j = 0; j < 4; ++j) hv[j] += fv[j] * gp[j] * r; }
        if (hout) {
#pragma unroll
            for (int j = 0; j < 4; ++j) *(f32x4*)(hout + (size_t)m * D + 4 * lane + 256 * j) = hv[j]; }
        if (XN) { float s = 0.f;
#pragma unroll
            for (int j = 0; j < 4; ++j) s += (hv[j][0] * hv[j][0] + hv[j][1] * hv[j][1]) + (hv[j][2] * hv[j][2] + hv[j][3] * hv[j][3]);
            const float r = rsqrtf(wave_sum(s) * (1.f / D) + RMS_EPS);
#pragma unroll
            for (int j = 0; j < 4; ++j) { const f32x4 o = hv[j] * gq[j] * r; uint2 pk; pk.x = pk2(o[0], o[1]); pk.y = pk2(o[2], o[3]); *(uint2*)(XN + (size_t)m * D + 4 * lane + 256 * j) = pk; } }
    }
}
#define XIN (prm.in[0])
#define PIN (prm.in[1])
#define pos ((const int*)prm.in[2])
#define gains (prm.in[3])
#define wg (prm.in[4])
#define wu (prm.in[5])
#define wd (prm.in[6])
#define rwin (prm.in[7])
#define rwout (prm.in[9])
#define swin (prm.in[10])
#define swout (prm.in[11])
#define pwg (prm.in[12])
#define pwp (prm.in[13])
#define HH (prm.out)
#define XN ((bf16*)(prm.ws + WS_XN))
#define WGU ((bf16*)(prm.ws + WS_WFFN))
#define WDN (WGU + (size_t)2 * FF * D)
#define WIN ((bf16*)(prm.ws + WS_WMIX))
#define WOUT (WIN + (size_t)RIN * D)
#define WPG ((bf16*)(prm.ws + WS_WPLE))
#define WPP (WPG + (size_t)D * D)
#define PB ((bf16*)(prm.ws + WS_PB))
#define RC ((float*)(prm.ws + WS_ROPE))
#define RS (RC + (size_t)M * 128)
#define HID ((bf16*)(prm.ws + WS_BIG))
#define QKVG HID
#define EB ((float*)(prm.ws + WS_BIG))
#define F ((float*)(prm.ws + WS_ST))
#define STB ((bf16*)(prm.ws + WS_ST))
#define IN(k) (lo <= (k) && (k) < hi)
#define GEMM(EPI, E, Aptr, LDA, Bptr, NN, KK) do { pg8::Gemm g_{}; g_.A = (Aptr); g_.Bt = (Bptr); g_.M = M; g_.N = (NN); g_.K = (KK); g_.lda = (LDA); \
        pg8::StaticOrder S_; S_.init(M, (NN), G, bx); pg8::gemm_phase<EPI, pg8::StaticOrder, true, true>(lds, g_, S_, E); } while (0)
#define FFN_JOBS(layer, f) do { const size_t wo_ = ((size_t)(layer) * 2 + (f)) * D * FF; \
        ConvJob j1_{wg + wo_, WGU, D, FF, 128, 256, 0, 0, 0, 1.f}; convert_job(j1_, scr, gw, ngw, lane); \
        ConvJob j2_{wu + wo_, WGU, D, FF, 128, 256, 128, 0, 0, 1.f}; convert_job(j2_, scr, gw, ngw, lane); \
        ConvJob j3_{wd + wo_, WDN, FF, D, D, 0, 0, 0, 0, 1.f}; convert_job(j3_, scr, gw, ngw, lane); } while (0)
#define PLE_JOBS(layer) do { ConvJob j1_{pwg + (size_t)(layer) * D * D, WPG, D, D, D, 0, 0, 0, 0, 1.f}; convert_job(j1_, scr, gw, ngw, lane); \
        ConvJob j2_{pwp + (size_t)(layer) * PLE * D, WPP, PLE, D, D, 0, 0, 0, 0, 1.f}; convert_job(j2_, scr, gw, ngw, lane); \
        const float* ps_ = PIN + (size_t)(layer) * M * PLE; \
        for (size_t i_ = (size_t)gw * 64 + lane; i_ < (size_t)M * PLE / 4; i_ += (size_t)ngw * 64) { const f32x4 v_ = *(const f32x4*)(ps_ + i_ * 4); uint2 o_; o_.x = pk2(v_[0], v_[1]); o_.y = pk2(v_[2], v_[3]); *(uint2*)(PB + i_ * 4) = o_; } } while (0)
#define FFN_PHASES(base) do { \
        if (IN((base) + 0)) { pg8::EpiSwiglu E_{}; E_.O = HID; E_.ldc = FF; GEMM(pg8::EpiSwiglu, E_, XN, D, WGU, 2 * FF, D); } SEAM((base) + 0); \
        if (IN((base) + 1)) { pg8::EpiF32 E_{}; E_.C = F; E_.ldc = D; GEMM(pg8::EpiF32, E_, HID, FF, WDN, D, FF); } SEAM((base) + 1); } while (0)
#define PLE_PHASES(base) do { \
        if (IN((base) + 0)) { pg8::EpiF32 E_{}; E_.C = EB; E_.ldc = D; GEMM(pg8::EpiF32, E_, PB, PLE, WPP, D, PLE); } SEAM((base) + 0); \
        if (IN((base) + 1)) { pg8::EpiGateMul E_{}; E_.C = F; E_.E = EB; E_.ldc = D; GEMM(pg8::EpiGateMul, E_, XN, D, WPG, D, D); } SEAM((base) + 1); } while (0)

constexpr int NPP = 27, PH_LAST = 2 * NPP, N_PHASES = PH_LAST + 1;
#define SEAM(k) do { if (IN(k) && IN((k) + 1)) xcd_barrier(bar); } while (0)
template <int lp> __device__ __forceinline__ void layer_pair(const Params& prm, const XcdBarrier& bar, LAS unsigned char* lds, LAS float* scr, int gw, int ngw, int lane, int G, int bx, int lo, int hi) {
    const int pb = lp * NPP, lr = 2 * lp, lsb = 2 * lp + 1;
    const float* gr = gains + (size_t)lr * 8 * D; const float* gs = gains + (size_t)lsb * 8 * D;
    if (IN(pb + 0)) {
        if (lp == 0) { thin_rows(XIN, HH, nullptr, nullptr, 0.f, gr + 0 * D, XN, gw, ngw, lane);
            for (size_t i = (size_t)gw * 64 + lane; i < (size_t)M * 128; i += (size_t)ngw * 64) { const int d = (int)(i & 127), row = (int)(i >> 7);
                const float inv = powf(10000.f, -(float)d / 128.f), ang = (float)pos[row] * inv; RC[i] = cosf(ang); RS[i] = sinf(ang); } }
        else thin_rows(HH, HH, F, gains + (size_t)(lr - 1) * 8 * D + 7 * D, 1.f, gr + 0 * D, XN, gw, ngw, lane);
        FFN_JOBS(lr, 0);
    }
    SEAM(pb + 0);
    FFN_PHASES(pb + 1);
    if (IN(pb + 3)) { thin_rows(HH, HH, F, gr + 1 * D, 0.5f, gr + 2 * D, XN, gw, ngw, lane);
        ConvJob j1{rwin + (size_t)lp * D * RIN, WIN, D, RIN, RIN, 0, 0, RQK, 2 * RQK, 0.0625f}; convert_job(j1, scr, gw, ngw, lane);
        ConvJob j2{rwout + (size_t)lp * RV * D, WOUT, RV, D, D, 0, 0, 0, 0, 1.f}; convert_job(j2, scr, gw, ngw, lane); }
    SEAM(pb + 3);
    if (IN(pb + 4)) { pg8::EpiRetIn E_{}; E_.O = QKVG; E_.cs = RC; E_.sn = RS; GEMM(pg8::EpiRetIn, E_, XN, D, WIN, RIN, D); }
    SEAM(pb + 4);
    if (IN(pb + 5)) ret::scan_phase(QKVG, STB, lds, G, bx);
    SEAM(pb + 5);
    if (IN(pb + 6)) ret::out_phase(QKVG, STB, prm.in[8] + (size_t)lp * RV, lds, G, bx);
    SEAM(pb + 6);
    if (IN(pb + 7)) { pg8::EpiF32 E_{}; E_.C = F; E_.ldc = D; GEMM(pg8::EpiF32, E_, QKVG + 2 * RQK + RV, RIN, WOUT, D, RV); }
    SEAM(pb + 7);
    if (IN(pb + 8)) { thin_rows(HH, HH, F, gr + 3 * D, 1.f, gr + 4 * D, XN, gw, ngw, lane); FFN_JOBS(lr, 1); }
    SEAM(pb + 8);
    FFN_PHASES(pb + 9);
    if (IN(pb + 11)) { thin_rows(HH, HH, F, gr + 5 * D, 0.5f, gr + 6 * D, XN, gw, ngw, lane); PLE_JOBS(lr); }
    SEAM(pb + 11);
    PLE_PHASES(pb + 12);
    if (IN(pb + 14)) { thin_rows(HH, HH, F, gr + 7 * D, 1.f, gs + 0 * D, XN, gw, ngw, lane); FFN_JOBS(lsb, 0); }
    SEAM(pb + 14);
    FFN_PHASES(pb + 15);
    if (IN(pb + 17)) { thin_rows(HH, HH, F, gs + 1 * D, 0.5f, gs + 2 * D, XN, gw, ngw, lane);
        ConvJob j1{swin + (size_t)lp * D * SIN, WIN, D, SIN, SIN, 0, 0, 0, SW, 0.08838834764831845f * 1.4426950408889634f}; convert_job(j1, scr, gw, ngw, lane);
        ConvJob j2{swout + (size_t)lp * SW * D, WOUT, SW, D, D, 0, 0, 0, 0, 1.f}; convert_job(j2, scr, gw, ngw, lane); }
    SEAM(pb + 17);
    if (IN(pb + 18)) { pg8::EpiBf16 E_{}; E_.O = QKVG; E_.ldc = SIN; GEMM(pg8::EpiBf16, E_, XN, D, WIN, SIN, D); }
    SEAM(pb + 18);
    if (IN(pb + 19)) sba::sb_phase(QKVG, XN, lds, G, bx);
    SEAM(pb + 19);
    if (IN(pb + 20)) { pg8::EpiF32 E_{}; E_.C = F; E_.ldc = D; GEMM(pg8::EpiF32, E_, XN, D, WOUT, D, SW); }
    SEAM(pb + 20);
    if (IN(pb + 21)) { thin_rows(HH, HH, F, gs + 3 * D, 1.f, gs + 4 * D, XN, gw, ngw, lane); FFN_JOBS(lsb, 1); }
    SEAM(pb + 21);
    FFN_PHASES(pb + 22);
    if (IN(pb + 24)) { thin_rows(HH, HH, F, gs + 5 * D, 0.5f, gs + 6 * D, XN, gw, ngw, lane); PLE_JOBS(lsb); }
    SEAM(pb + 24);
    PLE_PHASES(pb + 25);
}
__global__ void __launch_bounds__(NTHR, 2) mega(Params prm) {
    extern __shared__ __attribute__((aligned(16))) unsigned char lds_raw[];
    LAS unsigned char* lds = (LAS unsigned char*)lds_raw;
    const int tid = threadIdx.x, lane = tid & 63, wave = __builtin_amdgcn_readfirstlane(tid >> 6);
    const int G = gridDim.x, bx = blockIdx.x, vcu = (G % 8 == 0) ? (bx % 8) * (G / 8) + bx / 8 : bx;
    const int gw = vcu * NWAVES + wave, ngw = G * NWAVES;
    LAS float* scr = (LAS float*)(lds + wave * 16384);
    const int lo = prm.ph_lo, hi = prm.ph_hi;
    volatile LAS unsigned* misc = (volatile LAS unsigned*)(lds + LDS_MISC);
    if (tid < 4) misc[tid] = 0u;
    __syncthreads();
    const XcdBarrier bar = xcd_barrier_post((unsigned*)(prm.ws + WS_CTL), misc);
    layer_pair<0>(prm, bar, lds, scr, gw, ngw, lane, G, bx, lo, hi);
    layer_pair<1>(prm, bar, lds, scr, gw, ngw, lane, G, bx, lo, hi);
    if (IN(PH_LAST)) thin_rows(HH, HH, F, gains + (size_t)3 * 8 * D + 7 * D, 1.f, nullptr, nullptr, gw, ngw, lane);
}
#undef XIN
#undef PIN
#undef pos
#undef gains
#undef wg
#undef wu
#undef wd
#undef rwin
#undef rwout
#undef swin
#undef swout
#undef pwg
#undef pwp
#undef HH
#undef XN
#undef WGU
#undef WDN
#undef WIN
#undef WOUT
#undef WPG
#undef WPP
#undef PB
#undef RC
#undef RS
#undef HID
#undef QKVG
#undef EB
#undef F
#undef STB
#undef IN
#undef GEMM
#undef FFN_JOBS
#undef PLE_JOBS
#undef FFN_PHASES
#undef PLE_PHASES
#undef SEAM

extern "C" void kernel_launch(void* const* d_in, const int* in_sizes, int n_in, void* d_out, int out_size, void* d_ws, size_t ws_size, hipStream_t stream) {
    if (n_in != 14 || ws_size < WS_END) { fprintf(stderr, "kernel_launch: need 14 inputs and %zu bytes of workspace (got %d, %zu)\n", (size_t)WS_END, n_in, ws_size); return; }
    (void)hipFuncSetAttribute((const void*)mega, hipFuncAttributeMaxDynamicSharedMemorySize, LDS_BYTES);
    static int grid = 0;
    if (!grid) { int dev = 0, cus = 0; (void)hipGetDevice(&dev); (void)hipDeviceGetAttribute(&cus, hipDeviceAttributeMultiprocessorCount, dev); grid = cus > 0 ? cus : 256; }
    (void)hipMemsetAsync((char*)d_ws + WS_CTL, 0, CTL_ZERO_BYTES, stream);
    Params prm{};
    for (int i = 0; i < 14; ++i) prm.in[i] = (const float*)d_in[i];
    prm.out = (float*)d_out; prm.ws = (unsigned char*)d_ws; prm.ph_lo = 0; prm.ph_hi = N_PHASES;
    hipLaunchKernelGGL(mega, dim3(grid), dim3(NTHR), LDS_BYTES, stream, prm);
}
```

```cpp
#include <hip/hip_runtime.h>
#include <cstdio>
#include <cstdint>

constexpr int D = 1024, BATCH = 4, SEQ = 4096, DEPTH = 4, M = BATCH * SEQ;
constexpr int PLE = 256, FF = 2816;
constexpr int RH = 4, RDK = 256, RDV = 512, RQK = 1024, RV = 2048, RIN = 6144;
constexpr int SH = 8, SDH = 128, SW = 1024, SIN = 3072;
constexpr float RMS_EPS = 1e-6f, GN_EPS = 1e-5f;
#define LAS __attribute__((address_space(3)))
typedef unsigned short bf16;
typedef unsigned v4u __attribute__((ext_vector_type(4)));
typedef float f32x4 __attribute__((ext_vector_type(4)));
__device__ __forceinline__ unsigned f2bf(float f) { unsigned u = __builtin_bit_cast(unsigned, f); return (u + 0x7fffu + ((u >> 16) & 1u)) >> 16; }
__device__ __forceinline__ unsigned pk2(float lo, float hi) { return f2bf(lo) | (f2bf(hi) << 16); }
#define XB_TMO      128
#define XB_XCNT(j)  (256  + 64 * (j))
#define XB_XSUB(j)  (1280 + 64 * (j))
#define XB_XGEN(j)  (2304 + 64 * (j))
#define XB_TOP      3328
#define XB_TOPGEN   3392
#define XCD_BAR_WORDS 3456
#define XB_SPIN_CAP (1u << 18)

__device__ __forceinline__ unsigned xb_ld(unsigned* p)              { return __hip_atomic_load(p, __ATOMIC_RELAXED, __HIP_MEMORY_SCOPE_AGENT); }
__device__ __forceinline__ unsigned xb_add(unsigned* p, unsigned v) { return __hip_atomic_fetch_add(p, v, __ATOMIC_RELAXED, __HIP_MEMORY_SCOPE_AGENT); }
__device__ __forceinline__ unsigned xb_xcc_id() { return (unsigned)__builtin_amdgcn_s_getreg((3 << 11) | 20) & 0xFu; }
#define XB_SPIN(cond, bar) do { unsigned _sp = 0; while (cond) { __builtin_amdgcn_s_sleep(1); \
    if ((++_sp & 255u) == 0u) { if (xb_ld(&(bar)[XB_TMO])) break; if (_sp > XB_SPIN_CAP) { atomicAdd(&(bar)[XB_TMO], 1u); break; } } } } while (0)

struct XcdBarrier {
    unsigned* bar; unsigned x;
    volatile LAS unsigned* st;
};

__device__ __forceinline__ XcdBarrier xcd_barrier_post(unsigned* bar, volatile LAS unsigned* st) {
    XcdBarrier b; b.bar = bar; b.x = xb_xcc_id(); b.st = st;
    if (threadIdx.x == 0) (void)xb_add(&bar[XB_XCNT(b.x)], 1u);
    return b;
}
__device__ __forceinline__ void xcd_barrier_complete(unsigned* bar, unsigned x, unsigned& nloc, unsigned& nx) {
    const unsigned G = gridDim.x * gridDim.y * gridDim.z;
    unsigned sum, cnt, mine, sp = 0u;
    for (;;) {
        sum = 0u; cnt = 0u; mine = 0u;
#pragma unroll
        for (unsigned j = 0; j < 16; ++j) { const unsigned c = xb_ld(&bar[XB_XCNT(j)]); sum += c; cnt += (c > 0u) ? 1u : 0u; mine = (j == x) ? c : mine; }
        if (sum == G) break;
        __builtin_amdgcn_s_sleep(1);
        if ((++sp & 255u) == 0u) { if (xb_ld(&bar[XB_TMO])) break; if (sp > XB_SPIN_CAP) { atomicAdd(&bar[XB_TMO], 1u); break; } }
    }
    nloc = mine > 0u ? mine : 1u; nx = cnt > 0u ? cnt : 1u;
}

__device__ __forceinline__ void xcd_barrier(const XcdBarrier& b) {
    asm volatile("s_waitcnt vmcnt(0)" ::: "memory");
    __syncthreads();
    if (threadIdx.x == 0) {
        unsigned* bar = b.bar;
        __builtin_amdgcn_s_waitcnt(0);
        unsigned nloc = b.st[0], nx = b.st[1];
        if (nloc == 0u) { xcd_barrier_complete(bar, b.x, nloc, nx); b.st[0] = nloc; b.st[1] = nx; }
        const unsigned old = xb_add(&bar[XB_XSUB(b.x)], 1u);
        const unsigned gen = old / nloc;
        if (old + 1u == (gen + 1u) * nloc) {
            __builtin_amdgcn_fence(__ATOMIC_RELEASE, "agent");
            asm volatile("s_waitcnt vmcnt(0)" ::: "memory");
            const unsigned og = xb_add(&bar[XB_TOP], 1u);
            const unsigned tg = og / nx;
            if (og + 1u == (tg + 1u) * nx) xb_add(&bar[XB_TOPGEN], 1u);
            else XB_SPIN(xb_ld(&bar[XB_TOPGEN]) == tg, bar);
            __builtin_amdgcn_fence(__ATOMIC_ACQUIRE, "agent");
            xb_add(&bar[XB_XGEN(b.x)], 1u);
            asm volatile("s_waitcnt vmcnt(0)" ::: "memory");
        } else {
            XB_SPIN(xb_ld(&bar[XB_XGEN(b.x)]) == gen, bar);
            __builtin_amdgcn_fence(__ATOMIC_ACQUIRE, "agent");
            asm volatile("s_waitcnt vmcnt(0)" ::: "memory");
        }
    }
    __syncthreads();
}

namespace pg8 {
#define PG8_LAS __attribute__((address_space(3)))
typedef unsigned short bf16_t;
typedef short bf16x8 __attribute__((ext_vector_type(8)));
typedef float f32x4 __attribute__((ext_vector_type(4)));
typedef unsigned u32x4 __attribute__((ext_vector_type(4)));
constexpr int BM = 256, BK = 64, HALF = 128, HTB = HALF * BK * 2  , STAGE_BYTES = 8 * HTB, NXCD = 8, WGM = 8;

__host__ __device__ __forceinline__ int lds_byte(int r, int c) { const int st = (r >> 4) * 2 + (c >> 5), rr = r & 15, cc = c & 31, ob = rr * 64 + cc * 2; return st * 1024 + (ob ^ (((ob >> 9) & 1) << 5)); }
__host__ __device__ __forceinline__ void stage_rc(int b, int& R, int& C) { const int st = b / 1024, sb = b % 1024, swz = sb ^ (((sb >> 9) & 1) << 5); R = (st >> 1) * 16 + swz / 64; C = (st & 1) * 32 + (swz % 64) / 2; }
__host__ __device__ __forceinline__ int perm32(int rho) { const int n = rho >> 4, i = rho & 15; return 8 * (i >> 2) + 4 * n + (i & 3); }

struct Unit { int pm, pn; };
struct Gemm { const bf16_t* A; const bf16_t* Bt; int M, N, K, lda; };

struct StaticOrder {
    int nM, nN, nwg, G, c;
    __host__ __device__ void init(int M, int N, int G_, int c_) { nM = M / BM; nN = N / BM; nwg = nM * nN; G = G_; c = c_; }
    __host__ __device__ bool next(int i, Unit& u) const {
        const long L = (long)i * G + c; if (L >= nwg) return false;
        int wgid = (int)L; { const int q = nwg / NXCD, r = nwg % NXCD, xcd = wgid % NXCD, off = wgid / NXCD; wgid = (xcd < r ? xcd * (q + 1) : r * (q + 1) + (xcd - r) * q) + off; }
        const int nig = WGM * nN, gid = wgid / nig, fm = gid * WGM, gsz = (nM - fm) < WGM ? (nM - fm) : WGM;
        u.pm = fm + ((wgid % nig) % gsz); u.pn = (wgid % nig) / gsz; return true;
    }
    __device__ __forceinline__ void a_ready(const Unit&) const {}
    __device__ __forceinline__ void done(const Unit&) const {}
};
__device__ __forceinline__ unsigned cvt_pk_bf16(float lo, float hi) { unsigned r; asm volatile("v_cvt_pk_bf16_f32 %0, %1, %2" : "=v"(r) : "v"(lo), "v"(hi)); return r; }
typedef float f32x2 __attribute__((ext_vector_type(2)));
__device__ __forceinline__ float silu_fast(float x) { return x * __builtin_amdgcn_rcpf(1.f + __builtin_amdgcn_exp2f(-1.4426950408889634f * x)); }
__device__ __forceinline__ float sigmoid_fast(float x) { return __builtin_amdgcn_rcpf(1.f + __builtin_amdgcn_exp2f(-1.4426950408889634f * x)); }
__device__ __forceinline__ u32x4 pack8v(const f32x4 a, const f32x4 b) { u32x4 w; w.x = cvt_pk_bf16(a[0], a[1]); w.y = cvt_pk_bf16(a[2], a[3]); w.z = cvt_pk_bf16(b[0], b[1]); w.w = cvt_pk_bf16(b[2], b[3]); return w; }
__device__ __forceinline__ float bflo(unsigned u) { return __builtin_bit_cast(float, u << 16); }
__device__ __forceinline__ float bfhi(unsigned u) { return __builtin_bit_cast(float, u & 0xffff0000u); }
struct EpiBf16 {
    static constexpr bool PERM = true, AFTER_DRAIN = false;
    bf16_t* O; const float* rs; int ldc; int pad;
    __device__ __forceinline__ void operator()(const f32x4 (&acc)[2][2][4][2], const Unit& u, int wr, int wc, int fr, int fq) const {
        const int row0 = u.pm * BM + wr * 64 + fr, col0 = u.pn * BM + wc * 32 + 8 * fq;
#pragma unroll
        for (int ai = 0; ai < 2; ++ai)
#pragma unroll
            for (int m = 0; m < 4; ++m) { const int row = row0 + ai * HALF + m * 16; bf16_t* rowp = O + (size_t)row * ldc + col0; const float r = rs ? rs[row] : 1.f;
#pragma unroll
                for (int bj = 0; bj < 2; ++bj) *(u32x4*)(rowp + bj * HALF) = pack8v(acc[ai][bj][m][0] * r, acc[ai][bj][m][1] * r); }
    }
    __device__ __forceinline__ void fused(f32x4 (&acc)[2][2][4][2], const Unit& u, int wr, int wc, int fr, int fq, PG8_LAS unsigned char* lds, int wid, int lane) const {}
};
struct EpiGateMul {
    static constexpr bool PERM = true, AFTER_DRAIN = false;
    bf16_t* O; const bf16_t* E; const float* rs; int ldc; int pad;
    __device__ __forceinline__ void operator()(const f32x4 (&acc)[2][2][4][2], const Unit& u, int wr, int wc, int fr, int fq) const {
        const int row0 = u.pm * BM + wr * 64 + fr, col0 = u.pn * BM + wc * 32 + 8 * fq;
#pragma unroll
        for (int ai = 0; ai < 2; ++ai)
#pragma unroll
            for (int m = 0; m < 4; ++m) { const int row = row0 + ai * HALF + m * 16; const size_t off = (size_t)row * ldc + col0; const float r = rs[row];
#pragma unroll
                for (int bj = 0; bj < 2; ++bj) { const u32x4 e = *(const u32x4*)(E + off + bj * HALF); const f32x4 a0 = acc[ai][bj][m][0] * r, a1 = acc[ai][bj][m][1] * r; f32x4 v0, v1;
                    v0[0] = sigmoid_fast(a0[0]) * bflo(e.x); v0[1] = sigmoid_fast(a0[1]) * bfhi(e.x); v0[2] = sigmoid_fast(a0[2]) * bflo(e.y); v0[3] = sigmoid_fast(a0[3]) * bfhi(e.y);
                    v1[0] = sigmoid_fast(a1[0]) * bflo(e.z); v1[1] = sigmoid_fast(a1[1]) * bfhi(e.z); v1[2] = sigmoid_fast(a1[2]) * bflo(e.w); v1[3] = sigmoid_fast(a1[3]) * bfhi(e.w);
                    *(u32x4*)(O + off + bj * HALF) = pack8v(v0, v1); } }
    }
    __device__ __forceinline__ void fused(f32x4 (&acc)[2][2][4][2], const Unit& u, int wr, int wc, int fr, int fq, PG8_LAS unsigned char* lds, int wid, int lane) const {}
};
struct EpiSwiglu {
    static constexpr bool PERM = true, AFTER_DRAIN = false;
    bf16_t* O; const float* rs; int ldc; int pad;
    __device__ __forceinline__ void operator()(const f32x4 (&acc)[2][2][4][2], const Unit& u, int wr, int wc, int fr, int fq) const {
        const int row0 = u.pm * BM + wr * 64 + fr, col0 = u.pn * HALF + wc * 32 + 8 * fq;
#pragma unroll
        for (int ai = 0; ai < 2; ++ai)
#pragma unroll
            for (int m = 0; m < 4; ++m) { const int row = row0 + ai * HALF + m * 16; bf16_t* rowp = O + (size_t)row * ldc + col0; const float r = rs[row]; f32x4 v0, v1;
#pragma unroll
                for (int j = 0; j < 4; ++j) { v0[j] = silu_fast(acc[ai][0][m][0][j] * r) * (acc[ai][1][m][0][j] * r); v1[j] = silu_fast(acc[ai][0][m][1][j] * r) * (acc[ai][1][m][1][j] * r); }
                *(u32x4*)rowp = pack8v(v0, v1); }
    }
    __device__ __forceinline__ void fused(f32x4 (&acc)[2][2][4][2], const Unit& u, int wr, int wc, int fr, int fq, PG8_LAS unsigned char* lds, int wid, int lane) const {}
};
struct EpiRetIn {
    static constexpr bool PERM = true, AFTER_DRAIN = false;
    bf16_t* O; const float* cs; const float* sn; const float* rs;
    __device__ __forceinline__ void operator()(const f32x4 (&acc)[2][2][4][2], const Unit& u, int wr, int wc, int fr, int fq) const {
        const int row0 = u.pm * BM + wr * 64 + fr, d0 = wc * 32 + 8 * fq, ldc = 6144;
        if (u.pn < 8) {
            const int hd = u.pn & 3; const float l2g = __builtin_log2f(1.f - __builtin_exp2f(-5.f - (float)hd)) * (u.pn < 4 ? 1.f : -1.f);
#pragma unroll
            for (int ai = 0; ai < 2; ++ai)
#pragma unroll
                for (int m = 0; m < 4; ++m) { const int row = row0 + ai * HALF + m * 16; bf16_t* rowp = O + (size_t)row * ldc + u.pn * BM + d0;
                    const float dec = __builtin_amdgcn_exp2f(l2g * (float)(row & 127)) * rs[row];
                    const f32x4 c0 = *(const f32x4*)(cs + (size_t)row * 128 + d0), c1 = *(const f32x4*)(cs + (size_t)row * 128 + d0 + 4);
                    const f32x4 s0 = *(const f32x4*)(sn + (size_t)row * 128 + d0), s1 = *(const f32x4*)(sn + (size_t)row * 128 + d0 + 4);
                    const f32x4 a0 = acc[ai][0][m][0], a1 = acc[ai][0][m][1], b0 = acc[ai][1][m][0], b1 = acc[ai][1][m][1];
                    *(u32x4*)rowp = pack8v((a0 * c0 - b0 * s0) * dec, (a1 * c1 - b1 * s1) * dec);
                    *(u32x4*)(rowp + HALF) = pack8v((a0 * s0 + b0 * c0) * dec, (a1 * s1 + b1 * c1) * dec); }
        } else {
            const bool gate = u.pn >= 16;
#pragma unroll
            for (int ai = 0; ai < 2; ++ai)
#pragma unroll
                for (int m = 0; m < 4; ++m) { const int row = row0 + ai * HALF + m * 16; bf16_t* rowp = O + (size_t)row * ldc + u.pn * BM + d0; const float r = rs[row];
#pragma unroll
                    for (int bj = 0; bj < 2; ++bj) { f32x4 v0 = acc[ai][bj][m][0] * r, v1 = acc[ai][bj][m][1] * r;
                        if (gate) {
#pragma unroll
                            for (int j = 0; j < 4; ++j) { v0[j] = silu_fast(v0[j]); v1[j] = silu_fast(v1[j]); } }
                        *(u32x4*)(rowp + bj * HALF) = pack8v(v0, v1); } }
        }
    }
    __device__ __forceinline__ void fused(f32x4 (&acc)[2][2][4][2], const Unit& u, int wr, int wc, int fr, int fq, PG8_LAS unsigned char* lds, int wid, int lane) const {}
};
template <class Epi, class Sched, bool ALIGN_EPI = false, bool SP2 = false>
__device__ __forceinline__ void gemm_phase(PG8_LAS unsigned char* lds, const Gemm g, const Sched& S, const Epi& E) {
    const int tid = threadIdx.x, wid = __builtin_amdgcn_readfirstlane(tid >> 6), lane = tid & 63, wr = wid >> 2, wc = wid & 3, fr = lane & 15, fq = lane >> 4;
    const int K = g.K, nt = K / BK;
    unsigned voffA[2], voffB[2];
#pragma unroll
    for (int i = 0; i < 2; ++i) { int R, C; stage_rc(tid * 16 + i * 8192, R, C); const int Rb = Epi::PERM ? ((R & ~31) + perm32(R & 31)) : R;
        voffA[i] = (unsigned)(R * g.lda + C) * 2u; voffB[i] = (unsigned)(Rb * K + C) * 2u; }
    const size_t kstep = (size_t)(BK * 2);
    const size_t hstep = (size_t)HALF * K * 2;
    const size_t tstep = 2 * hstep, hstepA = (size_t)HALF * g.lda * 2, tstepA = 2 * hstepA;
    const unsigned ldsw = (unsigned)wid * 1024u;
    const int aoff = lds_byte(wr * 64 + fr, fq * 8), boff = lds_byte(wc * 32 + fr, fq * 8);
#define PG8_SA(b, h) (((b) * 2 + (h)) * HTB)
#define PG8_SB(b, h) ((4 + (b) * 2 + (h)) * HTB)
#define PG8_STAGE(bufoff, gbase, voff) do { _Pragma("unroll") for (int _i = 0; _i < 2; ++_i) \
        __builtin_amdgcn_global_load_lds((const unsigned*)((const char*)(gbase) + (voff)[_i]), (PG8_LAS unsigned*)(lds + (bufoff) + ldsw + _i * 8192), 16, 0, 0); } while (0)
#define PG8_LDA(dst, b, h) do { _Pragma("unroll") for (int m = 0; m < 4; ++m) _Pragma("unroll") for (int k = 0; k < 2; ++k) dst[m][k] = *(const PG8_LAS bf16x8*)(lds + PG8_SA(b, h) + aoff + m * 2048 + k * 1024); } while (0)
#define PG8_LDB(dst, b, h) do { _Pragma("unroll") for (int n = 0; n < 2; ++n) _Pragma("unroll") for (int k = 0; k < 2; ++k) dst[n][k] = *(const PG8_LAS bf16x8*)(lds + PG8_SB(b, h) + boff + n * 2048 + k * 1024); } while (0)
#define PG8_MMA(ai, bj, At, Bt) do { __builtin_amdgcn_s_setprio(1); _Pragma("unroll") for (int m = 0; m < 4; ++m) _Pragma("unroll") for (int n = 0; n < 2; ++n) _Pragma("unroll") for (int k = 0; k < 2; ++k) \
        acc[ai][bj][m][n] = __builtin_amdgcn_mfma_f32_16x16x32_bf16(Bt[n][k], At[m][k], acc[ai][bj][m][n], 0, 0, 0); __builtin_amdgcn_s_setprio(0); } while (0)
#define PG8_WAIT_V(n) asm volatile("s_waitcnt vmcnt(" #n ")" ::: "memory")
#define PG8_WAIT_L(n) asm volatile("s_waitcnt lgkmcnt(" #n ")" ::: "memory")
#define PG8_BAR __builtin_amdgcn_s_barrier()
#define PG8_SCHED __builtin_amdgcn_sched_barrier(0)
    Unit cur, nxt; int ui = 0;
    if (!S.next(0, cur)) return;
    f32x4 acc[2][2][4][2];
#pragma unroll
    for (int a = 0; a < 2; ++a)
#pragma unroll
        for (int b = 0; b < 2; ++b)
#pragma unroll
            for (int m = 0; m < 4; ++m)
#pragma unroll
                for (int n = 0; n < 2; ++n) acc[a][b][m][n] = (f32x4){0.f, 0.f, 0.f, 0.f};
    bf16x8 At[4][2], B0[2][2], B1[2][2];
    const char* cA = (const char*)g.A + (size_t)cur.pm * tstepA; const char* cB = (const char*)g.Bt + (size_t)cur.pn * tstep;
    S.a_ready(cur);
    if constexpr (SP2) {
        PG8_STAGE(PG8_SB(0, 0), cB, voffB); PG8_STAGE(PG8_SB(0, 1), cB + hstep, voffB); PG8_STAGE(PG8_SA(0, 0), cA, voffA); PG8_STAGE(PG8_SA(0, 1), cA + hstepA, voffA);
        if (wr == 1) PG8_BAR;
        PG8_WAIT_V(2); PG8_BAR;
        PG8_STAGE(PG8_SB(1, 0), cB + kstep, voffB); PG8_STAGE(PG8_SA(1, 0), cA + kstep, voffA); PG8_STAGE(PG8_SB(1, 1), cB + hstep + kstep, voffB);
        PG8_WAIT_V(6); PG8_BAR;
    } else {
        PG8_STAGE(PG8_SB(0, 0), cB, voffB); PG8_STAGE(PG8_SA(0, 0), cA, voffA); PG8_STAGE(PG8_SB(0, 1), cB + hstep, voffB); PG8_STAGE(PG8_SA(0, 1), cA + hstepA, voffA);
        if (wr == 1) PG8_BAR;
        PG8_WAIT_V(4); PG8_BAR;
        PG8_STAGE(PG8_SB(1, 0), cB + kstep, voffB); PG8_STAGE(PG8_SA(1, 0), cA + kstep, voffA); PG8_STAGE(PG8_SB(1, 1), cB + hstep + kstep, voffB);
        PG8_WAIT_V(6); PG8_BAR;
    }
    for (;;) {
        const bool has_next = S.next(ui + 1, nxt);
        const char* nA = has_next ? (const char*)g.A + (size_t)nxt.pm * tstepA : cA; const char* nB = has_next ? (const char*)g.Bt + (size_t)nxt.pn * tstep : cB;
        for (int t = 0; t < nt; t += 2) {
            const bool last = (t == nt - 2);
            const char* a1 = cA + (size_t)(t + 1) * kstep;
            const char* a2 = last ? nA : cA + (size_t)(t + 2) * kstep; const char* b2 = last ? nB : cB + (size_t)(t + 2) * kstep;
            const char* a3 = a2 + kstep; const char* b3 = b2 + kstep;
            if (last && has_next) S.a_ready(nxt);
            if constexpr (SP2) {
            PG8_LDB(B0, 0, 0); PG8_LDB(B1, 0, 1); PG8_SCHED; PG8_LDA(At, 0, 0); PG8_STAGE(PG8_SA(1, 1), a1 + hstepA, voffA);
            PG8_WAIT_V(8); PG8_WAIT_L(0); PG8_BAR; PG8_MMA(0, 0, At, B0); PG8_MMA(0, 1, At, B1); PG8_BAR; PG8_SCHED;
            PG8_LDA(At, 0, 1); PG8_STAGE(PG8_SB(0, 0), b2, voffB); PG8_STAGE(PG8_SB(0, 1), b2 + hstep, voffB); PG8_STAGE(PG8_SA(0, 0), a2, voffA);
            PG8_WAIT_V(8); PG8_WAIT_L(0); PG8_BAR; PG8_MMA(1, 0, At, B0); PG8_MMA(1, 1, At, B1); PG8_BAR; PG8_SCHED;
            PG8_LDB(B0, 1, 0); PG8_LDB(B1, 1, 1); PG8_SCHED; PG8_LDA(At, 1, 0); PG8_STAGE(PG8_SA(0, 1), a2 + hstepA, voffA);
            PG8_WAIT_V(8); PG8_WAIT_L(0); PG8_BAR; PG8_MMA(0, 0, At, B0); PG8_MMA(0, 1, At, B1); PG8_BAR; PG8_SCHED;
            PG8_LDA(At, 1, 1); PG8_STAGE(PG8_SB(1, 0), b3, voffB); PG8_STAGE(PG8_SB(1, 1), b3 + hstep, voffB); PG8_STAGE(PG8_SA(1, 0), a3, voffA);
            PG8_WAIT_V(8); PG8_WAIT_L(0); PG8_BAR; PG8_MMA(1, 0, At, B0); PG8_MMA(1, 1, At, B1); PG8_BAR; PG8_SCHED;
            } else {
            PG8_LDB(B0, 0, 0); PG8_SCHED; PG8_LDA(At, 0, 0); PG8_STAGE(PG8_SA(1, 1), a1 + hstepA, voffA);
            PG8_WAIT_L(8); PG8_BAR; PG8_WAIT_L(0); PG8_MMA(0, 0, At, B0); PG8_BAR; PG8_SCHED;
            PG8_LDB(B1, 0, 1); PG8_STAGE(PG8_SB(0, 0), b2, voffB);
            PG8_BAR; PG8_WAIT_L(0); PG8_MMA(0, 1, At, B1); PG8_BAR;
            PG8_LDA(At, 0, 1); PG8_STAGE(PG8_SA(0, 0), a2, voffA);
            PG8_BAR; PG8_WAIT_L(0); PG8_MMA(1, 0, At, B0); PG8_BAR; PG8_SCHED;
            PG8_STAGE(PG8_SB(0, 1), b2 + hstep, voffB);
            PG8_WAIT_V(6); PG8_BAR; PG8_MMA(1, 1, At, B1); PG8_BAR;
            PG8_LDB(B0, 1, 0); PG8_SCHED; PG8_LDA(At, 1, 0); PG8_STAGE(PG8_SA(0, 1), a2 + hstepA, voffA);
            PG8_WAIT_L(8); PG8_BAR; PG8_WAIT_L(0); PG8_MMA(0, 0, At, B0); PG8_BAR; PG8_SCHED;
            PG8_LDB(B1, 1, 1); PG8_STAGE(PG8_SB(1, 0), b3, voffB);
            PG8_BAR; PG8_WAIT_L(0); PG8_MMA(0, 1, At, B1); PG8_BAR;
            PG8_LDA(At, 1, 1); PG8_STAGE(PG8_SA(1, 0), a3, voffA);
            PG8_BAR; PG8_WAIT_L(0); PG8_MMA(1, 0, At, B0); PG8_BAR; PG8_SCHED;
            PG8_STAGE(PG8_SB(1, 1), b3 + hstep, voffB);
            PG8_WAIT_V(6); PG8_BAR; PG8_MMA(1, 1, At, B1); PG8_BAR;
            }
        }
        if constexpr (ALIGN_EPI) { if (wr == 0) PG8_BAR; }
        if constexpr (!Epi::AFTER_DRAIN) { E(acc, cur, wr, wc, fr, fq); S.done(cur); }
        if (!has_next) break;
#pragma unroll
        for (int a = 0; a < 2; ++a)
#pragma unroll
            for (int b = 0; b < 2; ++b)
#pragma unroll
                for (int m = 0; m < 4; ++m)
#pragma unroll
                    for (int n = 0; n < 2; ++n) acc[a][b][m][n] = (f32x4){0.f, 0.f, 0.f, 0.f};
        cur = nxt; cA = nA; cB = nB; ++ui;
        if constexpr (ALIGN_EPI) { if (wr == 1) PG8_BAR; }
    }
    PG8_WAIT_V(0);
    if constexpr (!ALIGN_EPI) { if (wr == 0) PG8_BAR; }
    PG8_BAR;
    if constexpr (Epi::AFTER_DRAIN) { E.fused(acc, cur, wr, wc, fr, fq, lds, wid, lane); S.done(cur); }
#undef PG8_SA
#undef PG8_SB
#undef PG8_STAGE
#undef PG8_LDA
#undef PG8_LDB
#undef PG8_MMA
#undef PG8_WAIT_V
#undef PG8_WAIT_L
#undef PG8_BAR
#undef PG8_SCHED
}
}
namespace sba {
typedef short bf16x8 __attribute__((ext_vector_type(8)));
typedef short s16x4 __attribute__((ext_vector_type(4)));
typedef float f32x16 __attribute__((ext_vector_type(16)));
typedef unsigned u32x4 __attribute__((ext_vector_type(4)));
constexpr int KVBLK = 64, SHM_V = KVBLK * 128 * 2, SHM_K = KVBLK * 128 * 2;
constexpr int LDS_V = 0, LDS_K = 2 * SHM_V, LDS_FLAG = 2 * SHM_V + 2 * SHM_K;
#define SB_KSWZ(row, colB) ((row) * 256 + ((colB) ^ (((row) & 7) << 4)))
__device__ __forceinline__ int v_st(int k, int c) { const int kk = (k & ~0xC) | ((k & 4) << 1) | ((k & 8) >> 1); return ((kk >> 3) * 4 + (c >> 5)) * 512 + ((kk & 7) * 32 + (c & 31)) * 2; }
__device__ __forceinline__ int v_rd_base(int lane) { return ((lane & 3) << 3) | (((lane >> 2) & 3) << 6) | (((lane >> 4) & 1) << 5) | (((lane >> 5) & 1) << 8); }
constexpr int v_rd_off(int d0, int ks, int half) { return d0 * 512 + ks * 4096 + half * 2048; }
__device__ __forceinline__ int crow(int r, int hi) { return (r & 3) + 8 * (r >> 2) + 4 * hi; }
__device__ __forceinline__ unsigned cvtpk(float lo, float hi) { unsigned r; asm volatile("v_cvt_pk_bf16_f32 %0, %1, %2" : "=v"(r) : "v"(lo), "v"(hi)); return r; }
#define SB_SBAR() __builtin_amdgcn_sched_barrier(0)
template <int KB>
__device__ __forceinline__ void qkt(f32x16& p0, f32x16& p1, LAS const unsigned char* K_lds, int r32, int hi, const bf16x8* qr) {
    p0 = f32x16{}; p1 = f32x16{};
    LAS const unsigned char* kb[4];
#pragma unroll
    for (int dd = 0; dd < 4; ++dd) kb[dd] = K_lds + KB * SHM_K + SB_KSWZ(r32, (dd * 16 + hi * 8) * 2);
#pragma unroll
    for (int d0 = 0; d0 < 8; ++d0) { LAS const unsigned char* a = kb[d0 & 3] + (d0 >> 2) * 128;
        const bf16x8 b0 = *(LAS const bf16x8*)a;
        const bf16x8 b1 = *(LAS const bf16x8*)(a + 32 * 256);
        p0 = __builtin_amdgcn_mfma_f32_32x32x16_bf16(b0, qr[d0], p0, 0, 0, 0);
        p1 = __builtin_amdgcn_mfma_f32_32x32x16_bf16(b1, qr[d0], p1, 0, 0, 0); }
}
template <int VB>
__device__ __forceinline__ void pv_tile(f32x16* o, int vb0, bf16x8 pa0, bf16x8 pa1, bf16x8 pa2, bf16x8 pa3) {
#define SB_TRRD(dst, off) asm volatile("ds_read_b64_tr_b16 %0, %1 offset:%2" : "=&v"(dst) : "v"(vb0), "i"(off) : "memory")
#define SB_PV_D0(d0) do { s16x4 l0, l1, l2, l3, h0, h1, h2, h3; constexpr int b_ = VB * SHM_V + v_rd_off(d0, 0, 0); \
        SB_TRRD(l0, b_); SB_TRRD(h0, b_ + 2048); SB_TRRD(l1, b_ + 4096); SB_TRRD(h1, b_ + 6144); SB_TRRD(l2, b_ + 8192); SB_TRRD(h2, b_ + 10240); SB_TRRD(l3, b_ + 12288); SB_TRRD(h3, b_ + 14336); \
        asm volatile("s_waitcnt lgkmcnt(0)" ::: "memory"); SB_SBAR(); \
        o[d0] = __builtin_amdgcn_mfma_f32_32x32x16_bf16(pa0, (bf16x8){l0[0], l0[1], l0[2], l0[3], h0[0], h0[1], h0[2], h0[3]}, o[d0], 0, 0, 0); \
        o[d0] = __builtin_amdgcn_mfma_f32_32x32x16_bf16(pa1, (bf16x8){l1[0], l1[1], l1[2], l1[3], h1[0], h1[1], h1[2], h1[3]}, o[d0], 0, 0, 0); \
        o[d0] = __builtin_amdgcn_mfma_f32_32x32x16_bf16(pa2, (bf16x8){l2[0], l2[1], l2[2], l2[3], h2[0], h2[1], h2[2], h2[3]}, o[d0], 0, 0, 0); \
        o[d0] = __builtin_amdgcn_mfma_f32_32x32x16_bf16(pa3, (bf16x8){l3[0], l3[1], l3[2], l3[3], h3[0], h3[1], h3[2], h3[3]}, o[d0], 0, 0, 0); } while (0)
    SB_PV_D0(0); SB_PV_D0(1); SB_PV_D0(2); SB_PV_D0(3);
#undef SB_PV_D0
#undef SB_TRRD
}
__device__ __forceinline__ float swap_pick(float a, float b, int hi) {
    auto rr = __builtin_amdgcn_permlane32_swap(__float_as_uint(a), __float_as_uint(b), false, false);
    return __uint_as_float(hi ? rr[0] : rr[1]);
}
__device__ __forceinline__ void sb_half(f32x16& p, float& R, int hi, bool need_mask, int dq, bf16x8& paA, bf16x8& paB) {
    f32x16 s;
#pragma unroll
    for (int r = 0; r < 16; ++r) s[r] = fmaxf(p[r], 0.f) + __builtin_amdgcn_logf(1.f + __builtin_amdgcn_exp2f(-__builtin_fabsf(p[r])));
    if (need_mask) { const float NEG = -__builtin_inff();
#pragma unroll
        for (int r = 0; r < 16; ++r) { const int c = (r & 3) + 8 * (r >> 2); if (!(c < dq)) { s[r] = 0.f; p[r] = NEG; } } }
    float LS[5];
    LS[4] = 0.f;
#pragma unroll
    for (int k = 3; k >= 0; --k) LS[k] = LS[k + 1] + ((s[4 * k] + s[4 * k + 1]) + (s[4 * k + 2] + s[4 * k + 3]));
    const float tot = LS[0] + swap_pick(LS[0], LS[0], hi);
#pragma unroll
    for (int k = 0; k < 4; ++k) {
        const float e3 = R - LS[k + 1] - swap_pick(LS[k], LS[k + 1], hi);
        const float e2 = e3 - s[4 * k + 3], e1 = e2 - s[4 * k + 2], e0 = e1 - s[4 * k + 1];
        p[4 * k + 3] = __builtin_amdgcn_exp2f(p[4 * k + 3] - s[4 * k + 3] + e3); p[4 * k + 2] = __builtin_amdgcn_exp2f(p[4 * k + 2] - s[4 * k + 2] + e2);
        p[4 * k + 1] = __builtin_amdgcn_exp2f(p[4 * k + 1] - s[4 * k + 1] + e1); p[4 * k + 0] = __builtin_amdgcn_exp2f(p[4 * k + 0] - s[4 * k + 0] + e0);
    }
    R -= tot;
#define SB_PK4(P, B_, OUT) do { unsigned a0 = cvtpk(P[B_+0], P[B_+1]), a1 = cvtpk(P[B_+2], P[B_+3]); unsigned b0 = cvtpk(P[B_+4], P[B_+5]), b1 = cvtpk(P[B_+6], P[B_+7]); \
        auto r0 = __builtin_amdgcn_permlane32_swap(a0, b0, false, false); auto r1 = __builtin_amdgcn_permlane32_swap(a1, b1, false, false); \
        u32x4 w = {r0[0], r1[0], r0[1], r1[1]}; OUT = *reinterpret_cast<bf16x8*>(&w); } while (0)
    SB_PK4(p, 0, paA); SB_PK4(p, 8, paB);
#undef SB_PK4
}
__device__ __forceinline__ void sb_tile(f32x16& p0, f32x16& p1, float& R, int hi, bool need_mask, int dq, bf16x8& pa0, bf16x8& pa1, bf16x8& pa2, bf16x8& pa3) {
    sb_half(p1, R, hi, need_mask, dq - 32, pa2, pa3);
    sb_half(p0, R, hi, need_mask, dq, pa0, pa1);
}
__device__ __forceinline__ void sb_block(const bf16* Qh, const bf16* Kh, const bf16* Vh, int ld, bf16* Oh, int ldo, int qb, LAS unsigned char* lds) {
    const int tid = threadIdx.x, wid = __builtin_amdgcn_readfirstlane(tid >> 6), lane = tid & 63, r32 = lane & 31, hi = lane >> 5;
    const int NT = 4 * (qb + 1);
    const int qlo = 256 * qb + 32 * wid, qm = qlo + r32 - 4 * hi;
    LAS unsigned char* V_lds = lds + LDS_V; LAS unsigned char* K_lds = lds + LDS_K; volatile LAS unsigned* flags = (volatile LAS unsigned*)(lds + LDS_FLAG);
    bf16x8 qr[8];
#pragma unroll
    for (int d0 = 0; d0 < 8; ++d0) qr[d0] = *(const bf16x8*)(Qh + (size_t)(qlo + r32) * ld + d0 * 16 + hi * 8);
    const int sr = tid >> 4, sc = (tid & 15) * 8, vst0 = v_st(sr, sc), vst1 = v_st(32 + sr, sc), kws = SB_KSWZ(sr, sc * 2);
    const int vb0 = (int)(unsigned)(size_t)V_lds + v_rd_base(lane);
    float R = 0.f; f32x16 o[4] = {}; bool done = false;
    bf16x8 st_k0, st_k1, st_v0, st_v1;
#define SB_LOAD(kb_) do { st_k0 = *(const bf16x8*)(Kh + (size_t)((kb_) + sr) * ld + sc); st_k1 = *(const bf16x8*)(Kh + (size_t)((kb_) + 32 + sr) * ld + sc); \
                          st_v0 = *(const bf16x8*)(Vh + (size_t)((kb_) + sr) * ld + sc); st_v1 = *(const bf16x8*)(Vh + (size_t)((kb_) + 32 + sr) * ld + sc); } while (0)
#define SB_WRITE(bf) do { *(LAS bf16x8*)(K_lds + (bf) * SHM_K + kws) = st_k0; *(LAS bf16x8*)(K_lds + (bf) * SHM_K + kws + 32 * 256) = st_k1; \
                          *(LAS bf16x8*)(V_lds + (bf) * SHM_V + vst0) = st_v0; *(LAS bf16x8*)(V_lds + (bf) * SHM_V + vst1) = st_v1; } while (0)
    SB_LOAD((NT - 1) * KVBLK); asm volatile("s_waitcnt vmcnt(0)" ::: "memory"); SB_WRITE(0);
    __syncthreads();
    bool all_done = false;
#define SB_STEP(t_, BUF) do { const int kb_ = (NT - 1 - (t_)) * KVBLK; \
        if ((t_) + 1 < NT) SB_LOAD(kb_ - KVBLK); \
        if (!done && kb_ < qlo + 31) { f32x16 p0, p1; bf16x8 pa0, pa1, pa2, pa3; \
            qkt<BUF>(p0, p1, K_lds, r32, hi, qr); \
            sb_tile(p0, p1, R, hi, kb_ + KVBLK - 1 >= qlo, qm - kb_, pa0, pa1, pa2, pa3); SB_SBAR(); \
            pv_tile<BUF>(o, vb0, pa0, pa1, pa2, pa3); \
            done = __all(R < -160.f); } \
        if ((t_) + 1 < NT) { asm volatile("s_waitcnt vmcnt(0)" ::: "memory"); SB_WRITE((BUF) ^ 1); } \
        if (lane == 0) flags[wid] = done ? 1u : 0u; \
        __syncthreads(); \
        { unsigned f_ = 1u; _Pragma("unroll") for (int w_ = 0; w_ < 8; ++w_) f_ &= flags[w_]; all_done = f_ != 0u; } \
        __syncthreads(); } while (0)
    for (int t = 0; t < NT; t += 2) { SB_STEP(t, 0); if (all_done) break; SB_STEP(t + 1, 1); if (all_done) break; }
#undef SB_STEP
#undef SB_LOAD
#undef SB_WRITE
    bf16* Ow = Oh + (size_t)qlo * ldo;
#pragma unroll
    for (int r = 0; r < 16; ++r) { const int orow = crow(r, hi);
#pragma unroll
        for (int d0 = 0; d0 < 4; ++d0) { const float v = o[d0][r]; const float vn = __shfl_xor(v, 1);
            if ((r32 & 1) == 0) *(unsigned*)(Ow + (size_t)orow * ldo + d0 * 32 + r32) = cvtpk(v, vn); } }
}
__device__ __forceinline__ void sb_phase(const bf16* QKV, bf16* AO, LAS unsigned char* lds, int G, int bx) {
    const int vcu = (G % 8 == 0) ? (bx % 8) * (G / 8) + bx / 8 : bx;
    for (int item = vcu; item < BATCH * SH * 8; item += G) {
        const int bh = item >> 3, y = item & 7, b = bh >> 3, h = bh & 7;
        const bf16* base = QKV + (size_t)b * SEQ * SIN + h * 128; bf16* ob = AO + (size_t)b * SEQ * SW + h * 128;
        sb_block(base, base + SW, base + 2 * SW, SIN, ob, SW, 15 - y, lds);
        sb_block(base, base + SW, base + 2 * SW, SIN, ob, SW, y, lds);
    }
}
}
namespace ret {
typedef short bf16x8 __attribute__((ext_vector_type(8)));
typedef short s16x4 __attribute__((ext_vector_type(4)));
typedef float f32x16 __attribute__((ext_vector_type(16)));
typedef unsigned u32x4 __attribute__((ext_vector_type(4)));
typedef unsigned u32x2 __attribute__((ext_vector_type(2)));
#define RT_TRRD(dst, addr, off) asm volatile("ds_read_b64_tr_b16 %0, %1 offset:%2" : "=&v"(dst) : "v"(addr), "i"(off) : "memory")
#define RT_CAT(l, h) ((bf16x8){l[0], l[1], l[2], l[3], h[0], h[1], h[2], h[3]})
constexpr int SC_KROW = 192, SC_VROW = 320, SC_KB = 128 * SC_KROW, SC_BUF = 65536;
__device__ __forceinline__ void scan_phase(const bf16* QKVG, bf16* ST, LAS unsigned char* lds, int G, int bx) {
    const int tid = threadIdx.x, wid = __builtin_amdgcn_readfirstlane(tid >> 6), lane = tid & 63, r32 = lane & 31, hi = lane >> 5;
    const int dkb = wid & 1, dvb = wid >> 1;
    const int trr = 8 * hi + ((lane >> 2) & 3), trc = 16 * ((lane >> 4) & 1) + 4 * (lane & 3);
    const int ka = (int)(unsigned)(size_t)lds + trr * SC_KROW + (32 * dkb + trc) * 2, va = (int)(unsigned)(size_t)lds + SC_KB + trr * SC_VROW + (32 * dvb + trc) * 2;
    const int kr0 = tid >> 3, kc0 = tid & 7, vr0 = tid >> 4, vc0 = tid & 15;
    for (int item = bx; item < BATCH * RH * 16; item += G) {
        const int bh = item >> 4, b = bh >> 2, h = bh & 3, dkq = (item >> 2) & 3, dvq = item & 3;
        const float l2g = __builtin_log2f(1.f - __builtin_exp2f(-5.f - (float)h));
        const float gam = __builtin_exp2f(l2g), g128 = __builtin_exp2f(128.f * l2g), g127 = __builtin_exp2f(127.f * l2g);
        const bf16* Kb = QKVG + (size_t)b * SEQ * RIN + RQK + h * RDK + dkq * 64 + (size_t)kr0 * RIN + kc0 * 8;
        const bf16* Vb = QKVG + (size_t)b * SEQ * RIN + 2 * RQK + h * RDV + dvq * 128 + (size_t)vr0 * RIN + vc0 * 8;
        bf16* sp0 = ST + ((size_t)((bh * 32) * 32 + 8 * dkq + 4 * dkb) * RDV + dvq * 128 + dvb * 32 + r32) * 8 + 4 * hi;
        f32x16 st = {};
        bf16x8 k0[6], k1[6], v0[6], v1[6], v2[6], v3[6];
#define RT_LOADC(c_, sl_) do { const size_t ro_ = (size_t)(c_) * 128 * RIN; k0[sl_] = *(const bf16x8*)(Kb + ro_); k1[sl_] = *(const bf16x8*)(Kb + ro_ + (size_t)64 * RIN); \
            v0[sl_] = *(const bf16x8*)(Vb + ro_); v1[sl_] = *(const bf16x8*)(Vb + ro_ + (size_t)32 * RIN); v2[sl_] = *(const bf16x8*)(Vb + ro_ + (size_t)64 * RIN); v3[sl_] = *(const bf16x8*)(Vb + ro_ + (size_t)96 * RIN); } while (0)
#define RT_SNAP(c_) do { bf16* sp_ = sp0 + (size_t)(c_) * 32 * RDV * 8; _Pragma("unroll") for (int g = 0; g < 4; ++g) { uint2 w_; w_.x = sba::cvtpk(st[4 * g] * gam, st[4 * g + 1] * gam); w_.y = sba::cvtpk(st[4 * g + 2] * gam, st[4 * g + 3] * gam); \
            *(uint2*)(sp_ + (size_t)g * RDV * 8) = w_; } } while (0)
#define RT_STEP(c_, sl_, par_) do { RT_SNAP(c_); \
            { LAS unsigned char* kb_ = lds + (par_) * SC_BUF; LAS unsigned char* vb_ = kb_ + SC_KB; \
              *(LAS bf16x8*)(kb_ + kr0 * SC_KROW + kc0 * 16) = k0[sl_]; *(LAS bf16x8*)(kb_ + (kr0 + 64) * SC_KROW + kc0 * 16) = k1[sl_]; \
              *(LAS bf16x8*)(vb_ + vr0 * SC_VROW + vc0 * 16) = v0[sl_]; *(LAS bf16x8*)(vb_ + (vr0 + 32) * SC_VROW + vc0 * 16) = v1[sl_]; \
              *(LAS bf16x8*)(vb_ + (vr0 + 64) * SC_VROW + vc0 * 16) = v2[sl_]; *(LAS bf16x8*)(vb_ + (vr0 + 96) * SC_VROW + vc0 * 16) = v3[sl_]; } \
            if ((c_) + 6 < 31) RT_LOADC((c_) + 6, sl_); \
            __syncthreads(); \
            { f32x16 acc_ = {}; \
              _Pragma("unroll") for (int s = 0; s < 8; ++s) { s16x4 a0_, a1_, b0_, b1_; \
                RT_TRRD(a0_, ka + (par_) * SC_BUF, s * 16 * SC_KROW); RT_TRRD(a1_, ka + (par_) * SC_BUF, s * 16 * SC_KROW + 4 * SC_KROW); \
                RT_TRRD(b0_, va + (par_) * SC_BUF, s * 16 * SC_VROW); RT_TRRD(b1_, va + (par_) * SC_BUF, s * 16 * SC_VROW + 4 * SC_VROW); \
                asm volatile("s_waitcnt lgkmcnt(0)" ::: "memory"); __builtin_amdgcn_sched_barrier(0); \
                acc_ = __builtin_amdgcn_mfma_f32_32x32x16_bf16(RT_CAT(a0_, a1_), RT_CAT(b0_, b1_), acc_, 0, 0, 0); } \
              _Pragma("unroll") for (int r = 0; r < 16; ++r) st[r] = g128 * st[r] + g127 * acc_[r]; } } while (0)
        __syncthreads();
        RT_LOADC(0, 0); RT_LOADC(1, 1); RT_LOADC(2, 2); RT_LOADC(3, 3); RT_LOADC(4, 4); RT_LOADC(5, 5);
        for (int c0 = 0; c0 < 30; c0 += 6) { RT_STEP(c0 + 0, 0, 0); RT_STEP(c0 + 1, 1, 1); RT_STEP(c0 + 2, 2, 0); RT_STEP(c0 + 3, 3, 1); RT_STEP(c0 + 4, 4, 0); RT_STEP(c0 + 5, 5, 1); }
        RT_STEP(30, 0, 0);
        RT_SNAP(31);
#undef RT_STEP
#undef RT_SNAP
#undef RT_LOADC
    }
}
constexpr int RO_Q = 0, RO_K = 65536, RO_V = 65536 + 16384, RO_VROW = 1088, RO_T = RO_V + 32 * RO_VROW, RO_OROW = 528;
#define RO_SWZ(row, colB) ((row) * 512 + ((colB) ^ (((row) & 15) << 4)))
__device__ __forceinline__ void out_phase(const bf16* QKVG, const bf16* ST, const float* gn, bf16* AO, int ldo, LAS unsigned char* lds, int G, int bx) {
    const int tid = threadIdx.x, wid = __builtin_amdgcn_readfirstlane(tid >> 6), lane = tid & 63, r32 = lane & 31, hi = lane >> 5;
    const int rb = wid & 3, dvh = wid >> 2;
    LAS unsigned char* Ql = lds + RO_Q; LAS unsigned char* Kl = lds + RO_K; LAS unsigned char* Vl = lds + RO_V; LAS float* Tt = (LAS float*)(lds + RO_T);
    const int va = (int)(unsigned)(size_t)Vl + (4 * hi + ((lane >> 2) & 3)) * RO_VROW + (256 * dvh + 16 * ((lane >> 4) & 1) + 4 * (lane & 3)) * 2;
    const int qr_ = tid >> 5, qc_ = tid & 31;
    const int vr_ = tid >> 6, vc_ = tid & 63;
    for (int unit = bx; unit < BATCH * RH * 32; unit += G) {
        const int bh = unit >> 5, c = unit & 31, b = bh >> 2, h = bh & 3;
        const size_t row0 = (size_t)b * SEQ + c * 128;
        const bf16* Qb = QKVG + row0 * RIN + h * RDK; const bf16* Kb = Qb + RQK; const bf16* Vb = QKVG + row0 * RIN + 2 * RQK + h * RDV;
        const bf16* Gb = QKVG + row0 * RIN + 2 * RQK + RV + h * RDV; bf16* Ab = AO + row0 * ldo + h * RDV;
        f32x16 o[8];
#pragma unroll
        for (int d = 0; d < 8; ++d) o[d] = f32x16{};
        bf16x8 kr[2], vr[4];
#define RO_LOADT(kt_) do { _Pragma("unroll") for (int i = 0; i < 2; ++i) kr[i] = *(const bf16x8*)(Kb + (size_t)(32 * (kt_) + qr_ + 16 * i) * RIN + qc_ * 8); \
                           _Pragma("unroll") for (int i = 0; i < 4; ++i) vr[i] = *(const bf16x8*)(Vb + (size_t)(32 * (kt_) + vr_ + 8 * i) * RIN + vc_ * 8); } while (0)
#define RO_WRITET() do { _Pragma("unroll") for (int i = 0; i < 2; ++i) *(LAS bf16x8*)(Kl + RO_SWZ(qr_ + 16 * i, qc_ * 16)) = kr[i]; \
                         _Pragma("unroll") for (int i = 0; i < 4; ++i) *(LAS bf16x8*)(Vl + (vr_ + 8 * i) * RO_VROW + vc_ * 16) = vr[i]; } while (0)
        __syncthreads();
        unsigned warm[8];
        if (c != 0) { const unsigned* wp = (const unsigned*)(ST + (size_t)(bh * 32 + c) * 32 * RDV * 8) + tid * 16;
#pragma unroll
            for (int i = 0; i < 8; ++i) warm[i] = wp[i * 8192]; }
        { bf16x8 qv[8];
#pragma unroll
          for (int i = 0; i < 8; ++i) qv[i] = *(const bf16x8*)(Qb + (size_t)(qr_ + 16 * i) * RIN + qc_ * 8);
          RO_LOADT(0);
#pragma unroll
          for (int i = 0; i < 8; ++i) *(LAS bf16x8*)(Ql + RO_SWZ(qr_ + 16 * i, qc_ * 16)) = qv[i];
          RO_WRITET(); }
        __syncthreads();
#pragma unroll
        for (int kt = 0; kt < 4; ++kt) {
            if (kt < 3) RO_LOADT(kt + 1);
            if (kt <= rb) {
                f32x16 p = {};
#pragma unroll 4
                for (int s = 0; s < 16; ++s) {
                    const bf16x8 af = *(LAS const bf16x8*)(Kl + RO_SWZ(r32, (2 * s + hi) * 16));
                    const bf16x8 qf = *(LAS const bf16x8*)(Ql + RO_SWZ(32 * rb + r32, (2 * s + hi) * 16));
                    p = __builtin_amdgcn_mfma_f32_32x32x16_bf16(af, qf, p, 0, 0, 0); }
                if (kt == rb) { const int dq = r32 - 4 * hi + 1;
#pragma unroll
                    for (int r = 0; r < 16; ++r) { const int cc = (r & 3) + 8 * (r >> 2); if (!(cc < dq)) p[r] = 0.f; } }
#pragma unroll
                for (int s2 = 0; s2 < 2; ++s2) {
                    u32x4 w; w.x = sba::cvtpk(p[8 * s2 + 0], p[8 * s2 + 1]); w.y = sba::cvtpk(p[8 * s2 + 2], p[8 * s2 + 3]); w.z = sba::cvtpk(p[8 * s2 + 4], p[8 * s2 + 5]); w.w = sba::cvtpk(p[8 * s2 + 6], p[8 * s2 + 7]);
                    const bf16x8 pb = *reinterpret_cast<bf16x8*>(&w);
#pragma unroll
                    for (int d = 0; d < 8; ++d) { s16x4 a0, a1;
                        RT_TRRD(a0, va, (16 * s2) * RO_VROW + d * 64); RT_TRRD(a1, va, (16 * s2 + 8) * RO_VROW + d * 64);
                        asm volatile("s_waitcnt lgkmcnt(0)" ::: "memory"); __builtin_amdgcn_sched_barrier(0);
                        o[d] = __builtin_amdgcn_mfma_f32_32x32x16_bf16(RT_CAT(a0, a1), pb, o[d], 0, 0, 0); }
                }
            }
            if (kt < 3) { __syncthreads(); RO_WRITET(); __syncthreads(); }
        }
#undef RO_LOADT
#undef RO_WRITET
        if (c != 0) {
#pragma unroll
            for (int i = 0; i < 8; ++i) asm volatile("" :: "v"(warm[i]));
            const bf16* sp = ST + ((size_t)((bh * 32 + c) * 32 + hi) * RDV + 256 * dvh + r32) * 8;
            bf16x8 fa[8], fb[8];
#define RO_LDS_(dst, s_) do { _Pragma("unroll") for (int d = 0; d < 8; ++d) dst[d] = *(const bf16x8*)(sp + ((size_t)(2 * (s_)) * RDV + 32 * d) * 8); } while (0)
#define RO_MMS_(src, s_) do { const bf16x8 qf = *(LAS const bf16x8*)(Ql + RO_SWZ(32 * rb + r32, (2 * (s_) + hi) * 16)); \
                              _Pragma("unroll") for (int d = 0; d < 8; ++d) o[d] = __builtin_amdgcn_mfma_f32_32x32x16_bf16(src[d], qf, o[d], 0, 0, 0); } while (0)
            RO_LDS_(fa, 0);
#pragma unroll
            for (int s = 0; s < 16; s += 2) { RO_LDS_(fb, s + 1); RO_MMS_(fa, s); if (s + 2 < 16) RO_LDS_(fa, s + 2); RO_MMS_(fb, s + 1); }
#undef RO_LDS_
#undef RO_MMS_
        }
        float s1 = 0.f, s2 = 0.f;
#pragma unroll
        for (int d = 0; d < 8; ++d)
#pragma unroll
            for (int r = 0; r < 16; ++r) { s1 += o[d][r]; s2 += o[d][r] * o[d][r]; }
        s1 += sba::swap_pick(s1, s1, hi); s2 += sba::swap_pick(s2, s2, hi);
        if (hi == 0) { Tt[(dvh * 128 + 32 * rb + r32) * 2] = s1; Tt[(dvh * 128 + 32 * rb + r32) * 2 + 1] = s2; }
        __syncthreads();
        const float t1 = Tt[(32 * rb + r32) * 2] + Tt[(128 + 32 * rb + r32) * 2], t2 = Tt[(32 * rb + r32) * 2 + 1] + Tt[(128 + 32 * rb + r32) * 2 + 1];
        const float mu = t1 * (1.f / 512.f), rstd = rsqrtf(fmaxf(t2 * (1.f / 512.f) - mu * mu, 0.f) + GN_EPS);
        __syncthreads();
        LAS unsigned char* Wl = lds + wid * (32 * RO_OROW);
        const float* gnp = gn + h * RDV + 256 * dvh + 4 * hi;
#pragma unroll
        for (int d = 0; d < 8; ++d)
#pragma unroll
            for (int g = 0; g < 4; ++g) { const f32x4 gv = *(const f32x4*)(gnp + 32 * d + 8 * g);
                u32x2 w; w.x = sba::cvtpk((o[d][4 * g] - mu) * rstd * gv[0], (o[d][4 * g + 1] - mu) * rstd * gv[1]); w.y = sba::cvtpk((o[d][4 * g + 2] - mu) * rstd * gv[2], (o[d][4 * g + 3] - mu) * rstd * gv[3]);
                *(LAS u32x2*)(Wl + r32 * RO_OROW + (32 * d + 8 * g + 4 * hi) * 2) = w; }
        asm volatile("s_waitcnt lgkmcnt(0)" ::: "memory");
#pragma unroll 4
        for (int i = 0; i < 16; ++i) { const int id = i * 64 + lane, rr = id >> 5, ch = id & 31;
            const u32x4 ov = *(LAS const u32x4*)(Wl + rr * RO_OROW + ch * 16);
            const size_t go = (size_t)(32 * rb + rr) * RIN + 256 * dvh + ch * 8; const u32x4 sg = *(const u32x4*)(Gb + go);
            u32x4 res;
#pragma unroll
            for (int e = 0; e < 4; ++e) res[e] = sba::cvtpk(__builtin_bit_cast(float, ov[e] << 16) * __builtin_bit_cast(float, sg[e] << 16), __builtin_bit_cast(float, ov[e] & 0xffff0000u) * __builtin_bit_cast(float, sg[e] & 0xffff0000u));
            *(u32x4*)(Ab + (size_t)(32 * rb + rr) * ldo + 256 * dvh + ch * 8) = res; }
    }
}
#undef RT_TRRD
#undef RT_CAT
}
constexpr int NWAVES = 8, NTHR = 512;
constexpr int LDS_MISC = 147200;
constexpr int LDS_BYTES = 147456;
constexpr size_t MiB = 1u << 20;
constexpr size_t WS_CTL = 0, CTL_ZERO_BYTES = 16384;
constexpr size_t WS_HB = 1 * MiB;
constexpr size_t WS_WFFN = WS_HB + (size_t)M * D * 2;
constexpr size_t WS_WMIX = WS_WFFN + (size_t)3 * D * FF * 2;
constexpr size_t WS_WPLE = WS_WMIX + (size_t)(RIN * D + RV * D) * 2;
constexpr size_t WS_PB = WS_WPLE + (size_t)(D * D + D * PLE) * 2;
constexpr size_t WS_ROPE = WS_PB + (size_t)M * PLE * 2;
constexpr size_t WS_RSTD = WS_ROPE + (size_t)M * 128 * 4 * 2;
constexpr size_t WS_EB = WS_RSTD + (size_t)M * 4;
constexpr size_t WS_BIG = WS_EB + (size_t)M * D * 2;
constexpr size_t WS_ST = WS_BIG + (size_t)M * RIN * 2;
constexpr size_t WS_END = WS_ST + (size_t)BATCH * RH * 32 * RDK * RDV * 2;
static_assert(WS_HB % 256 == 0 && WS_WFFN % 256 == 0 && WS_WMIX % 256 == 0 && WS_WPLE % 256 == 0 && WS_PB % 256 == 0 && WS_ROPE % 256 == 0 && WS_RSTD % 256 == 0 && WS_EB % 256 == 0 && WS_BIG % 256 == 0 && WS_ST % 256 == 0, "alignment");

struct Params { const float* in[14]; float* out; unsigned char* ws; int ph_lo, ph_hi; };

__device__ __forceinline__ float wave_sum(float v) {
#pragma unroll
    for (int o = 1; o < 64; o <<= 1) v += __shfl_xor(v, o);
    return v;
}
struct ConvJob { const float* W; bf16* WT; const float* gk; int K, N, grp, gstride, goff, s_lo, s_hi; float sc; };
__device__ __forceinline__ void transpose_item(const ConvJob& j, LAS float* scr, int k0, int n0, int lane) {
    const int dst_row0 = (n0 / j.grp) * j.gstride + j.goff + n0 % j.grp; const float sc = (n0 >= j.s_lo && n0 < j.s_hi) ? j.sc : 1.f;
#pragma unroll 8
    for (int i = 0; i < 32; ++i) { const int kk = 2 * i + (lane >> 5); scr[kk * 33 + (lane & 31)] = j.W[(size_t)(k0 + kk) * j.N + n0 + (lane & 31)]; }
    asm volatile("s_waitcnt lgkmcnt(0)" ::: "memory");
    const int c = lane & 7;
    f32x4 g0 = {sc, sc, sc, sc}, g1 = {sc, sc, sc, sc};
    if (j.gk) { g0 = *(const f32x4*)(j.gk + k0 + 8 * c) * sc; g1 = *(const f32x4*)(j.gk + k0 + 8 * c + 4) * sc; }
#pragma unroll
    for (int q = 0; q < 4; ++q) { const int n = (lane >> 3) + 8 * q; const LAS float* s = scr + (8 * c) * 33 + n;
        v4u o; o.x = pk2(s[0 * 33] * g0[0], s[1 * 33] * g0[1]); o.y = pk2(s[2 * 33] * g0[2], s[3 * 33] * g0[3]); o.z = pk2(s[4 * 33] * g1[0], s[5 * 33] * g1[1]); o.w = pk2(s[6 * 33] * g1[2], s[7 * 33] * g1[3]);
        *(v4u*)(j.WT + (size_t)(dst_row0 + n) * j.K + k0 + 8 * c) = o; }
    asm volatile("s_waitcnt lgkmcnt(0)" ::: "memory");
}
__device__ __forceinline__ void convert_job(const ConvJob& j, LAS float* scr, int gw, int ngw, int lane) {
    const int nblk = j.N / 32, nitems = (j.K / 64) * nblk;
    for (int it = gw; it < nitems; it += ngw) { const int kb = it / nblk, nb = it % nblk; transpose_item(j, scr, kb * 64, nb * 32, lane); }
}
template <int MODE>
__device__ __forceinline__ void thin_rows(const float* x, bf16* HB, const bf16* F, const float* gpost, float w, float* rstd, float* out, int gw, int ngw, int lane) {
    f32x4 gp[4];
#pragma unroll
    for (int j = 0; j < 4; ++j) gp[j] = F ? *(const f32x4*)(gpost + 8 * lane + 512 * (j >> 1) + 4 * (j & 1)) : (f32x4){0.f, 0.f, 0.f, 0.f};
    for (int m = gw; m < M; m += ngw) {
        f32x4 hv[4];
        if (MODE == 0) {
#pragma unroll
            for (int j = 0; j < 4; ++j) hv[j] = *(const f32x4*)(x + (size_t)m * D + 8 * lane + 512 * (j >> 1) + 4 * (j & 1));
        } else {
#pragma unroll
            for (int q = 0; q < 2; ++q) { const v4u u = *(const v4u*)(HB + (size_t)m * D + 8 * lane + 512 * q);
                hv[2 * q] = (f32x4){pg8::bflo(u.x), pg8::bfhi(u.x), pg8::bflo(u.y), pg8::bfhi(u.y)}; hv[2 * q + 1] = (f32x4){pg8::bflo(u.z), pg8::bfhi(u.z), pg8::bflo(u.w), pg8::bfhi(u.w)}; }
        }
        if (F) { f32x4 fv[4]; float s = 0.f;
#pragma unroll
            for (int q = 0; q < 2; ++q) { const v4u u = *(const v4u*)(F + (size_t)m * D + 8 * lane + 512 * q);
                fv[2 * q] = (f32x4){pg8::bflo(u.x), pg8::bfhi(u.x), pg8::bflo(u.y), pg8::bfhi(u.y)}; fv[2 * q + 1] = (f32x4){pg8::bflo(u.z), pg8::bfhi(u.z), pg8::bflo(u.w), pg8::bfhi(u.w)}; }
#pragma unroll
            for (int j = 0; j < 4; ++j) s += (fv[j][0] * fv[j][0] + fv[j][1] * fv[j][1]) + (fv[j][2] * fv[j][2] + fv[j][3] * fv[j][3]);
            const float r = w * rsqrtf(wave_sum(s) * (1.f / D) + RMS_EPS);
#pragma unroll
            for (int j = 0; j < 4; ++j) hv[j] += fv[j] * gp[j] * r; }
        if (MODE == 2) {
#pragma unroll
            for (int j = 0; j < 4; ++j) *(f32x4*)(out + (size_t)m * D + 8 * lane + 512 * (j >> 1) + 4 * (j & 1)) = hv[j];
        } else { float s = 0.f;
#pragma unroll
            for (int j = 0; j < 4; ++j) s += (hv[j][0] * hv[j][0] + hv[j][1] * hv[j][1]) + (hv[j][2] * hv[j][2] + hv[j][3] * hv[j][3]);
            s = wave_sum(s);
#pragma unroll
            for (int q = 0; q < 2; ++q) { v4u o; o.x = pk2(hv[2 * q][0], hv[2 * q][1]); o.y = pk2(hv[2 * q][2], hv[2 * q][3]); o.z = pk2(hv[2 * q + 1][0], hv[2 * q + 1][1]); o.w = pk2(hv[2 * q + 1][2], hv[2 * q + 1][3]);
                *(v4u*)(HB + (size_t)m * D + 8 * lane + 512 * q) = o; }
            if (lane == 0) rstd[m] = rsqrtf(s * (1.f / D) + RMS_EPS); }
    }
}
#define XIN (prm.in[0])
#define PIN (prm.in[1])
#define pos ((const int*)prm.in[2])
#define gains (prm.in[3])
#define wg (prm.in[4])
#define wu (prm.in[5])
#define wd (prm.in[6])
#define rwin (prm.in[7])
#define rwout (prm.in[9])
#define swin (prm.in[10])
#define swout (prm.in[11])
#define pwg (prm.in[12])
#define pwp (prm.in[13])
#define HB ((bf16*)(prm.ws + WS_HB))
#define WGU ((bf16*)(prm.ws + WS_WFFN))
#define WDN (WGU + (size_t)2 * FF * D)
#define WIN ((bf16*)(prm.ws + WS_WMIX))
#define WOUT (WIN + (size_t)RIN * D)
#define WPG ((bf16*)(prm.ws + WS_WPLE))
#define WPP (WPG + (size_t)D * D)
#define PB ((bf16*)(prm.ws + WS_PB))
#define RC ((float*)(prm.ws + WS_ROPE))
#define RS (RC + (size_t)M * 128)
#define RSTD ((float*)(prm.ws + WS_RSTD))
#define EB ((bf16*)(prm.ws + WS_EB))
#define HID ((bf16*)(prm.ws + WS_BIG))
#define QKVG HID
#define AOS (HID + (size_t)M * SIN)
#define FB ((bf16*)(prm.ws + WS_ST))
#define STB ((bf16*)(prm.ws + WS_ST))
#define IN(k) (lo <= (k) && (k) < hi)
#define SEAM(k) do { if (IN(k) && IN((k) + 1)) xcd_barrier(bar); } while (0)
#define GEMMX(EPI, E, Aptr, LDA, Bptr, NN, KK, GG, CC) do { pg8::Gemm g_{}; g_.A = (Aptr); g_.Bt = (Bptr); g_.M = M; g_.N = (NN); g_.K = (KK); g_.lda = (LDA); \
        pg8::StaticOrder S_; S_.init(M, (NN), (GG), (CC)); pg8::gemm_phase<EPI, pg8::StaticOrder, true, true>(lds, g_, S_, E); } while (0)
#define GEMM(EPI, E, Aptr, LDA, Bptr, NN, KK) GEMMX(EPI, E, Aptr, LDA, Bptr, NN, KK, G, bx)
#define FFN_JOBS(layer, f, gk_) do { const size_t wo_ = ((size_t)(layer) * 2 + (f)) * D * FF; \
        ConvJob j1_{wg + wo_, WGU, (gk_), D, FF, 128, 256, 0, 0, 0, 1.f}; convert_job(j1_, scr, gw, ngw, lane); \
        ConvJob j2_{wu + wo_, WGU, (gk_), D, FF, 128, 256, 128, 0, 0, 1.f}; convert_job(j2_, scr, gw, ngw, lane); \
        ConvJob j3_{wd + wo_, WDN, nullptr, FF, D, D, 0, 0, 0, 0, 1.f}; convert_job(j3_, scr, gw, ngw, lane); } while (0)
#define PLE_JOBS(layer, gk_) do { ConvJob j1_{pwg + (size_t)(layer) * D * D, WPG, (gk_), D, D, D, 0, 0, 0, 0, 1.f}; convert_job(j1_, scr, gw, ngw, lane); \
        ConvJob j2_{pwp + (size_t)(layer) * PLE * D, WPP, nullptr, PLE, D, D, 0, 0, 0, 0, 1.f}; convert_job(j2_, scr, gw, ngw, lane); \
        const float* ps_ = PIN + (size_t)(layer) * M * PLE; \
        for (size_t i_ = (size_t)gw * 64 + lane; i_ < (size_t)M * PLE / 4; i_ += (size_t)ngw * 64) { const f32x4 v_ = *(const f32x4*)(ps_ + i_ * 4); uint2 o_; o_.x = pk2(v_[0], v_[1]); o_.y = pk2(v_[2], v_[3]); *(uint2*)(PB + i_ * 4) = o_; } } while (0)
#define FFN_PHASES(base, WITH_E) do { \
        if (IN((base) + 0)) { { pg8::EpiSwiglu E_{}; E_.O = HID; E_.rs = RSTD; E_.ldc = FF; GEMM(pg8::EpiSwiglu, E_, HB, D, WGU, 2 * FF, D); } \
            if ((WITH_E) && bx >= G / 2) { pg8::EpiBf16 E_{}; E_.O = EB; E_.rs = nullptr; E_.ldc = D; GEMMX(pg8::EpiBf16, E_, PB, PLE, WPP, D, PLE, G / 2, bx - G / 2); } } \
        SEAM((base) + 0); \
        if (IN((base) + 1)) { pg8::EpiBf16 E_{}; E_.O = FB; E_.rs = nullptr; E_.ldc = D; GEMM(pg8::EpiBf16, E_, HID, FF, WDN, D, FF); } SEAM((base) + 1); } while (0)
#define THIN(F_, gp_, w_) thin_rows<1>(nullptr, HB, (F_), (gp_), (w_), RSTD, nullptr, gw, ngw, lane)

constexpr int NPP = 25, PH_LAST = 2 * NPP, N_PHASES = PH_LAST + 1;
template <int lp> __device__ __forceinline__ void layer_pair(const Params& prm, const XcdBarrier& bar, LAS unsigned char* lds, LAS float* scr, int gw, int ngw, int lane, int G, int bx, int lo, int hi) {
    const int pb = lp * NPP, lr = 2 * lp, lsb = 2 * lp + 1;
    const float* gr = gains + (size_t)lr * 8 * D; const float* gs = gains + (size_t)lsb * 8 * D;
    if (IN(pb + 0)) {
        if (lp == 0) { thin_rows<0>(XIN, HB, nullptr, nullptr, 0.f, RSTD, nullptr, gw, ngw, lane);
            for (size_t i = (size_t)gw * 64 + lane; i < (size_t)M * 128; i += (size_t)ngw * 64) { const int d = (int)(i & 127), row = (int)(i >> 7);
                const float inv = powf(10000.f, -(float)d / 128.f), ang = (float)pos[row] * inv; RC[i] = cosf(ang); RS[i] = sinf(ang); } }
        else { THIN(FB, gains + (size_t)(lr - 1) * 8 * D + 7 * D, 1.f); }
        FFN_JOBS(lr, 0, gr + 0 * D);
    }
    SEAM(pb + 0);
    FFN_PHASES(pb + 1, false);
    if (IN(pb + 3)) { THIN(FB, gr + 1 * D, 0.5f);
        ConvJob j1{rwin + (size_t)lp * D * RIN, WIN, gr + 2 * D, D, RIN, RIN, 0, 0, RQK, 2 * RQK, 0.0625f}; convert_job(j1, scr, gw, ngw, lane);
        ConvJob j2{rwout + (size_t)lp * RV * D, WOUT, nullptr, RV, D, D, 0, 0, 0, 0, 1.f}; convert_job(j2, scr, gw, ngw, lane); }
    SEAM(pb + 3);
    if (IN(pb + 4)) { pg8::EpiRetIn E_{}; E_.O = QKVG; E_.cs = RC; E_.sn = RS; E_.rs = RSTD; GEMM(pg8::EpiRetIn, E_, HB, D, WIN, RIN, D); }
    SEAM(pb + 4);
    if (IN(pb + 5)) ret::scan_phase(QKVG, STB, lds, G, bx);
    SEAM(pb + 5);
    if (IN(pb + 6)) ret::out_phase(QKVG, STB, prm.in[8] + (size_t)lp * RV, QKVG + 2 * RQK + RV, RIN, lds, G, bx);
    SEAM(pb + 6);
    if (IN(pb + 7)) { pg8::EpiBf16 E_{}; E_.O = FB; E_.rs = nullptr; E_.ldc = D; GEMM(pg8::EpiBf16, E_, QKVG + 2 * RQK + RV, RIN, WOUT, D, RV); }
    SEAM(pb + 7);
    if (IN(pb + 8)) { THIN(FB, gr + 3 * D, 1.f); FFN_JOBS(lr, 1, gr + 4 * D); PLE_JOBS(lr, gr + 6 * D); }
    SEAM(pb + 8);
    FFN_PHASES(pb + 9, true);
    if (IN(pb + 11)) { THIN(FB, gr + 5 * D, 0.5f); }
    SEAM(pb + 11);
    if (IN(pb + 12)) { pg8::EpiGateMul E_{}; E_.O = FB; E_.E = EB; E_.rs = RSTD; E_.ldc = D; GEMM(pg8::EpiGateMul, E_, HB, D, WPG, D, D); }
    SEAM(pb + 12);
    if (IN(pb + 13)) { THIN(FB, gr + 7 * D, 1.f); FFN_JOBS(lsb, 0, gs + 0 * D); }
    SEAM(pb + 13);
    FFN_PHASES(pb + 14, false);
    if (IN(pb + 16)) { THIN(FB, gs + 1 * D, 0.5f);
        ConvJob j1{swin + (size_t)lp * D * SIN, WIN, gs + 2 * D, D, SIN, SIN, 0, 0, 0, SW, 0.08838834764831845f * 1.4426950408889634f}; convert_job(j1, scr, gw, ngw, lane);
        ConvJob j2{swout + (size_t)lp * SW * D, WOUT, nullptr, SW, D, D, 0, 0, 0, 0, 1.f}; convert_job(j2, scr, gw, ngw, lane); }
    SEAM(pb + 16);
    if (IN(pb + 17)) { pg8::EpiBf16 E_{}; E_.O = QKVG; E_.rs = RSTD; E_.ldc = SIN; GEMM(pg8::EpiBf16, E_, HB, D, WIN, SIN, D); }
    SEAM(pb + 17);
    if (IN(pb + 18)) sba::sb_phase(QKVG, AOS, lds, G, bx);
    SEAM(pb + 18);
    if (IN(pb + 19)) { pg8::EpiBf16 E_{}; E_.O = FB; E_.rs = nullptr; E_.ldc = D; GEMM(pg8::EpiBf16, E_, AOS, SW, WOUT, D, SW); }
    SEAM(pb + 19);
    if (IN(pb + 20)) { THIN(FB, gs + 3 * D, 1.f); FFN_JOBS(lsb, 1, gs + 4 * D); PLE_JOBS(lsb, gs + 6 * D); }
    SEAM(pb + 20);
    FFN_PHASES(pb + 21, true);
    if (IN(pb + 23)) { THIN(FB, gs + 5 * D, 0.5f); }
    SEAM(pb + 23);
    if (IN(pb + 24)) { pg8::EpiGateMul E_{}; E_.O = FB; E_.E = EB; E_.rs = RSTD; E_.ldc = D; GEMM(pg8::EpiGateMul, E_, HB, D, WPG, D, D); }
    SEAM(pb + 24);
}
__global__ void __launch_bounds__(NTHR, 2) mega(Params prm) {
    extern __shared__ __attribute__((aligned(16))) unsigned char lds_raw[];
    LAS unsigned char* lds = (LAS unsigned char*)lds_raw;
    const int tid = threadIdx.x, lane = tid & 63, wave = __builtin_amdgcn_readfirstlane(tid >> 6);
    const int G = gridDim.x, bx = blockIdx.x, vcu = (G % 8 == 0) ? (bx % 8) * (G / 8) + bx / 8 : bx;
    const int gw = vcu * NWAVES + wave, ngw = G * NWAVES;
    LAS float* scr = (LAS float*)(lds + wave * 16384);
    const int lo = prm.ph_lo, hi = prm.ph_hi;
    volatile LAS unsigned* misc = (volatile LAS unsigned*)(lds + LDS_MISC);
    if (tid < 4) misc[tid] = 0u;
    __syncthreads();
    const XcdBarrier bar = xcd_barrier_post((unsigned*)(prm.ws + WS_CTL), misc);
    layer_pair<0>(prm, bar, lds, scr, gw, ngw, lane, G, bx, lo, hi);
    layer_pair<1>(prm, bar, lds, scr, gw, ngw, lane, G, bx, lo, hi);
    if (IN(PH_LAST)) thin_rows<2>(nullptr, HB, FB, gains + (size_t)3 * 8 * D + 7 * D, 1.f, nullptr, prm.out, gw, ngw, lane);
}
extern "C" void kernel_launch(void* const* d_in, const int* in_sizes, int n_in, void* d_out, int out_size, void* d_ws, size_t ws_size, hipStream_t stream) {
    if (n_in != 14 || ws_size < WS_END) { fprintf(stderr, "kernel_launch: need 14 inputs and %zu bytes of workspace (got %d, %zu)\n", (size_t)WS_END, n_in, ws_size); return; }
    (void)hipFuncSetAttribute((const void*)mega, hipFuncAttributeMaxDynamicSharedMemorySize, LDS_BYTES);
    static int grid = 0;
    if (!grid) { int dev = 0, cus = 0; (void)hipGetDevice(&dev); (void)hipDeviceGetAttribute(&cus, hipDeviceAttributeMultiprocessorCount, dev); grid = cus > 0 ? cus : 256; }
    (void)hipMemsetAsync((char*)d_ws + WS_CTL, 0, CTL_ZERO_BYTES, stream);
    Params prm{};
    for (int i = 0; i < 14; ++i) prm.in[i] = (const float*)d_in[i];
    prm.out = (float*)d_out; prm.ws = (unsigned char*)d_ws; prm.ph_lo = 0; prm.ph_hi = N_PHASES;
    hipLaunchKernelGGL(mega, dim3(grid), dim3(NTHR), LDS_BYTES, stream, prm);
}
```
